# Optimizing an MI355X kernel written in HIP

```python
import math
import jax, jax.numpy as jnp
from jax import lax
import numpy as np

D_MODEL = 4096
BATCH = 4
SEQ = 2048
DEPTH = 1

MIX_WIDTH = D_MODEL
W_A = MIX_WIDTH // 2
W_B = MIX_WIDTH - W_A
CHUNK = 128
A_HEADS = 16
A_HEAD_DIM = W_A // A_HEADS
HEAD_DIM = 128
B_HEADS = W_B // HEAD_DIM
B_KV_HEADS = 4
B_GROUP = B_HEADS // B_KV_HEADS
IDX_HEADS = 32
IDX_DIM = 128
TOPK_MAX = 256
Q_BLOCK = 128
NUM_BUCKETS = 32
MAX_DISTANCE = 128
EPS = 1e-6
NEG = -1e30

IN_SPLITS = (W_A, W_A, W_A,
             W_B, B_KV_HEADS * HEAD_DIM, B_KV_HEADS * HEAD_DIM, W_B,
             IDX_HEADS * IDX_DIM, IDX_DIM, IDX_HEADS)
N_IN = sum(IN_SPLITS)

kernel_name = "hybrid_gmlp_dsa_adaln_layer"


def rms_norm(x, g):
    xf = x.astype(jnp.float32)
    y = xf * lax.rsqrt(jnp.mean(xf * xf, axis=-1, keepdims=True) + EPS)
    return (y * g.astype(jnp.float32)).astype(x.dtype)


def layer_norm(x, g, b):
    xf = x.astype(jnp.float32)
    mu = jnp.mean(xf, axis=-1, keepdims=True)
    var = jnp.mean(jnp.square(xf - mu), axis=-1, keepdims=True)
    y = (xf - mu) * lax.rsqrt(var + EPS)
    return (y * g.astype(jnp.float32) + b.astype(jnp.float32)).astype(x.dtype)


def t5_bucket(dist):
    max_exact = NUM_BUCKETS // 2
    n = jnp.maximum(dist, 0)
    nf = jnp.maximum(n, 1).astype(jnp.float32)
    large = max_exact + (jnp.log(nf / max_exact) / math.log(MAX_DISTANCE / max_exact)
                         * (NUM_BUCKETS - max_exact)).astype(jnp.int32)
    large = jnp.minimum(large, NUM_BUCKETS - 1)
    return jnp.where(n < max_exact, n, large)


def chunked_sgu(u, v, ln_v_g, ln_v_b, w_s, b_s):
    B, S, _ = u.shape
    u = jax.nn.gelu(u)
    v = layer_norm(jax.nn.gelu(v), ln_v_g, ln_v_b)
    n_chunks = S // CHUNK
    v = v.reshape(B, n_chunks, CHUNK, A_HEADS, A_HEAD_DIM)
    u = u.reshape(B, n_chunks, CHUNK, A_HEADS, A_HEAD_DIM)
    ws = w_s * jnp.tril(jnp.ones((CHUNK, CHUNK), w_s.dtype))[None]
    sp = jnp.einsum('hts,bnshc->bnthc', ws, v) + b_s.T[None, None, :, :, None]
    return (u * sp).reshape(B, S, W_A)


def sparse_attention(q, k, v, q_idx, k_idx, w_idx, rel_bias, k_sel):
    B, S = q.shape[:2]
    n_blocks = S // Q_BLOCK
    s_pos = jnp.arange(S)
    qg = q.reshape(B, S, B_KV_HEADS, B_GROUP, HEAD_DIM)
    gather = jax.vmap(lambda seq, ids: seq[ids])
    k_idx32 = k_idx.astype(jnp.float32)

    def block(i):
        t0 = i * Q_BLOCK
        qb = lax.dynamic_slice_in_dim(qg, t0, Q_BLOCK, axis=1)
        qib = lax.dynamic_slice_in_dim(q_idx, t0, Q_BLOCK, axis=1)
        wib = lax.dynamic_slice_in_dim(w_idx, t0, Q_BLOCK, axis=1)
        t_pos = t0 + jnp.arange(Q_BLOCK)
        dots = jnp.einsum('bqhd,bsd->bqhs', qib.astype(jnp.float32), k_idx32)
        score = jnp.einsum('bqh,bqhs->bqs', wib.astype(jnp.float32), jax.nn.relu(dots))
        causal = s_pos[None, :] <= t_pos[:, None]
        score = jnp.where(causal[None], score, -jnp.inf)
        _, sel = lax.top_k(score, k_sel)
        valid = sel <= t_pos[None, :, None]
        ks = gather(k, sel)
        vs = gather(v, sel)
        logits = jnp.einsum('bqgrd,bqkgd->bqgrk', qb, ks).astype(jnp.float32) * (HEAD_DIM ** -0.5)
        bias = rel_bias[t5_bucket(t_pos[None, :, None] - sel)].astype(jnp.float32)
        bias = bias.reshape(B, Q_BLOCK, k_sel, B_KV_HEADS, B_GROUP).transpose(0, 1, 3, 4, 2)
        logits = jnp.where(valid[:, :, None, None, :], logits + bias, NEG)
        p = jax.nn.softmax(logits, axis=-1).astype(vs.dtype)
        o = jnp.einsum('bqgrk,bqkgd->bqgrd', p, vs)
        return o.reshape(B, Q_BLOCK, W_B)

    out = lax.map(block, jnp.arange(n_blocks))
    return out.transpose(1, 0, 2, 3).reshape(B, S, W_B)


def hybrid_layer(x, c, w_ada, b_ada, norm_g, w_in, ln_v_g, ln_v_b, w_s, b_s,
                 q_norm_g, k_norm_g, out_norm_a_g, out_norm_b_g, w_out, rel_bias, k_sel):
    B, S, D = x.shape
    mod = jax.nn.silu(c) @ w_ada + b_ada
    shift, scale, gate = jnp.split(mod, 3, axis=-1)
    h = rms_norm(x, norm_g) * (1 + scale[:, None, :]) + shift[:, None, :]
    z = h @ w_in
    offs = np.cumsum(IN_SPLITS)[:-1].tolist()
    uA, vA, gA, qB, kB, vB, gB, qI, kI, wI = jnp.split(z, offs, axis=-1)
    yA = chunked_sgu(uA, vA, ln_v_g, ln_v_b, w_s, b_s)
    q = rms_norm(qB.reshape(B, S, B_HEADS, HEAD_DIM), q_norm_g)
    k = rms_norm(kB.reshape(B, S, B_KV_HEADS, HEAD_DIM), k_norm_g)
    v = vB.reshape(B, S, B_KV_HEADS, HEAD_DIM)
    q_idx = qI.reshape(B, S, IDX_HEADS, IDX_DIM)
    w_idx = wI * (IDX_HEADS ** -0.5 * IDX_DIM ** -0.5)
    yB = sparse_attention(q, k, v, q_idx, kI, w_idx, rel_bias, k_sel)
    yA = rms_norm(yA, out_norm_a_g) * jax.nn.silu(gA)
    yB = rms_norm(yB, out_norm_b_g) * jax.nn.silu(gB)
    y = jnp.concatenate([yA, yB], axis=-1) @ w_out
    return x + gate[:, None, :] * y


def setup_inputs(seed: int = 0) -> dict:
    key = jax.random.key(seed)
    ks = jax.random.split(key, 16)
    f = jnp.float32
    nrm = lambda k, shape: jax.random.normal(k, shape, f)
    return {
        "x": nrm(ks[0], (BATCH, SEQ, D_MODEL)),
        "c": nrm(ks[1], (BATCH, D_MODEL)),
        "w_ada": nrm(ks[2], (DEPTH, D_MODEL, 3 * D_MODEL)) * (0.5 * D_MODEL ** -0.5),
        "b_ada": nrm(ks[3], (DEPTH, 3 * D_MODEL)) * 0.01,
        "norm_g": 1.0 + 0.02 * nrm(ks[4], (DEPTH, D_MODEL)),
        "w_in": nrm(ks[5], (DEPTH, D_MODEL, N_IN)) * D_MODEL ** -0.5,
        "ln_v_g": 1.0 + 0.02 * nrm(ks[6], (DEPTH, W_A)),
        "ln_v_b": 0.02 * nrm(ks[7], (DEPTH, W_A)),
        "w_s": nrm(ks[8], (DEPTH, A_HEADS, CHUNK, CHUNK)) * (0.5 * CHUNK ** -0.5),
        "b_s": 1.0 + 0.1 * nrm(ks[9], (DEPTH, A_HEADS, CHUNK)),
        "q_norm_g": 1.0 + 0.02 * nrm(ks[10], (DEPTH, HEAD_DIM)),
        "k_norm_g": 1.0 + 0.02 * nrm(ks[11], (DEPTH, HEAD_DIM)),
        "rel_bias": 0.5 * nrm(ks[12], (NUM_BUCKETS, B_HEADS)),
        "out_norm_a_g": 1.0 + 0.02 * nrm(ks[13], (DEPTH, W_A)),
        "out_norm_b_g": 1.0 + 0.02 * nrm(ks[14], (DEPTH, W_B)),
        "w_out": nrm(ks[15], (DEPTH, MIX_WIDTH, D_MODEL)) * MIX_WIDTH ** -0.5,
    }


def reference(x, c, w_ada, b_ada, norm_g, w_in, ln_v_g, ln_v_b, w_s, b_s,
              q_norm_g, k_norm_g, rel_bias, out_norm_a_g, out_norm_b_g, w_out):
    k_sel = min(TOPK_MAX, x.shape[1] // 4)
    for l in range(DEPTH):
        x = hybrid_layer(x, c, w_ada[l], b_ada[l], norm_g[l], w_in[l], ln_v_g[l], ln_v_b[l],
                         w_s[l], b_s[l], q_norm_g[l], k_norm_g[l], out_norm_a_g[l],
                         out_norm_b_g[l], w_out[l], rel_bias, k_sel)
    return x
```

```cpp
#include <hip/hip_runtime.h>
#include <hip/hip_cooperative_groups.h>
#include <cstdio>
#include <cstdint>
namespace cg = cooperative_groups;

#define LAS __attribute__((address_space(3)))
typedef _Float16 h8 __attribute__((ext_vector_type(8)));
typedef _Float16 h4 __attribute__((ext_vector_type(4)));
typedef _Float16 h2 __attribute__((ext_vector_type(2)));
typedef float f32x2 __attribute__((ext_vector_type(2)));
typedef float f32x4 __attribute__((ext_vector_type(4)));
typedef float f32x16 __attribute__((ext_vector_type(16)));
typedef unsigned u32x2 __attribute__((ext_vector_type(2)));
typedef unsigned u32x4 __attribute__((ext_vector_type(4)));

constexpr int NB = 4, SEQ = 2048, DM = 4096, NT = NB * SEQ;
constexpr int NZ = 15520, NZP = 15616;
constexpr int C_U = 0, C_V = 2048, C_GA = 4096, C_QB = 6144, C_KB = 8192, C_VB = 8704, C_GB = 9216, C_QI = 11264, C_KI = 15360, C_WI = 15488;
constexpr float EPS = 1e-6f;
constexpr int TOPK = 256;
constexpr int KSPLIT = 16;

constexpr size_t MiB = 1u << 20;
constexpr size_t WS_WTIN = 1 * MiB;
constexpr size_t WS_WTOUT = 123 * MiB;
constexpr size_t WS_H = 155 * MiB;
constexpr size_t WS_U = 219 * MiB;
constexpr size_t WS_V = 251 * MiB;
constexpr size_t WS_GA = 283 * MiB;
constexpr size_t WS_QB = 315 * MiB;
constexpr size_t WS_KB = 347 * MiB;
constexpr size_t WS_VV = 355 * MiB;
constexpr size_t WS_GB = 363 * MiB;
constexpr size_t WS_QI = 395 * MiB;
constexpr size_t WS_KI = 459 * MiB;
constexpr size_t WS_WI = 463 * MiB;
constexpr size_t WS_MODP = 464 * MiB;
constexpr size_t WS_MOD = 467 * MiB;
constexpr size_t WS_VSTAT = 468 * MiB;
constexpr size_t WS_MASK = 470 * MiB;
constexpr size_t WS_Y = 472 * MiB;
constexpr size_t WS_SSQA = 536 * MiB;
constexpr size_t WS_SSQB = 537 * MiB;
constexpr size_t WS_KN = 538 * MiB;
constexpr size_t WS_WS16 = 546 * MiB;
constexpr size_t WS_END = 547 * MiB;

constexpr int LDS_BYTES = 147456;
constexpr int LDS_X = 131072;

__device__ __forceinline__ float wave_sum(float v) {
#pragma unroll
    for (int o = 1; o < 64; o <<= 1) v += __shfl_xor(v, o);
    return v;
}
__device__ __forceinline__ float wave_max(float v) {
#pragma unroll
    for (int o = 1; o < 64; o <<= 1) v = fmaxf(v, __shfl_xor(v, o));
    return v;
}
__device__ __forceinline__ unsigned pk_h2(float lo, float hi) { h2 v = {(_Float16)lo, (_Float16)hi}; return __builtin_bit_cast(unsigned, v); }
__device__ __forceinline__ float fast_exp(float x) { return __builtin_amdgcn_exp2f(x * 1.44269504089f); }
__device__ __forceinline__ float gelu_tanh(float x) {
    const float u = 1.5957691216f * (x + 0.044715f * x * x * x);
    return x * __builtin_amdgcn_rcpf(1.0f + fast_exp(-u));
}
__device__ __forceinline__ float relu1(float x) { float r; asm("v_max_f32 %0, 0, %1" : "=v"(r) : "v"(x)); return r; }
__device__ __forceinline__ float silu_f(float x) { return x * __builtin_amdgcn_rcpf(1.0f + fast_exp(-x)); }
__device__ __forceinline__ unsigned cvtpk_bf16(float lo, float hi) { unsigned r; asm volatile("v_cvt_pk_bf16_f32 %0, %1, %2" : "=v"(r) : "v"(lo), "v"(hi)); return r; }

namespace pg8 {
constexpr int BM = 256, BK = 64, HALF = 128, HTB = HALF * BK * 2, STAGE_BYTES = 8 * HTB, NXCD = 8, WGM = 8;
__host__ __device__ __forceinline__ int lds_byte(int r, int c) { const int st = (r >> 4) * 2 + (c >> 5), rr = r & 15, cc = c & 31, ob = rr * 64 + cc * 2; return st * 1024 + (ob ^ (((ob >> 9) & 1) << 5)); }
__host__ __device__ __forceinline__ void stage_rc(int b, int& R, int& C) { const int st = b / 1024, sb = b % 1024, swz = sb ^ (((sb >> 9) & 1) << 5); R = (st >> 1) * 16 + swz / 64; C = (st & 1) * 32 + (swz % 64) / 2; }
__host__ __device__ __forceinline__ int perm32(int rho) { const int n = rho >> 4, i = rho & 15; return 8 * (i >> 2) + 4 * n + (i & 3); }
struct Unit { int pm, pn; };
struct Gemm { const _Float16* A; const _Float16* Bt; int M, N, K; };
struct StaticOrder {
    int nM, nN, nwg, G, c;
    __host__ __device__ void init(int M, int N, int G_, int c_) { nM = M / BM; nN = N / BM; nwg = nM * nN; G = G_; c = c_; }
    __host__ __device__ bool next(int i, Unit& u) const {
        const long L = (long)i * G + c; if (L >= nwg) return false;
        int wgid = (int)L; { const int q = nwg / NXCD, r = nwg % NXCD, xcd = wgid % NXCD, off = wgid / NXCD; wgid = (xcd < r ? xcd * (q + 1) : r * (q + 1) + (xcd - r) * q) + off; }
        const int nig = WGM * nN, gid = wgid / nig, fm = gid * WGM, gsz = (nM - fm) < WGM ? (nM - fm) : WGM;
        u.pm = fm + ((wgid % nig) % gsz); u.pn = (wgid % nig) / gsz; return true;
    }
};

template <class Epi, bool ALIGN_EPI = true, bool SP2 = true>
__device__ __forceinline__ void gemm_phase(LAS unsigned char* lds, const Gemm g, const StaticOrder& S, const Epi& E) {
    const int tid = threadIdx.x, wid = __builtin_amdgcn_readfirstlane(tid >> 6), lane = tid & 63, wr = wid >> 2, wc = wid & 3, fr = lane & 15, fq = lane >> 4;
    const int K = g.K, nt = K / BK;
    unsigned voffA[2], voffB[2];
#pragma unroll
    for (int i = 0; i < 2; ++i) { int R, C; stage_rc(tid * 16 + i * 8192, R, C); const int Rb = Epi::PERM ? ((R & ~31) + perm32(R & 31)) : R;
        voffA[i] = (unsigned)(R * K + C) * 2u; voffB[i] = (unsigned)(Rb * K + C) * 2u; }
    const size_t kstep = (size_t)(BK * 2);
    const size_t hstep = (size_t)HALF * K * 2;
    const size_t tstep = 2 * hstep;
    const unsigned ldsw = (unsigned)wid * 1024u;
    const int aoff = lds_byte(wr * 64 + fr, fq * 8), boff = lds_byte(wc * 32 + fr, fq * 8);
#define PG8_SA(b, h) (((b) * 2 + (h)) * HTB)
#define PG8_SB(b, h) ((4 + (b) * 2 + (h)) * HTB)
#define PG8_STAGE(bufoff, gbase, voff) do { _Pragma("unroll") for (int _i = 0; _i < 2; ++_i) \
        __builtin_amdgcn_global_load_lds((const unsigned*)((const char*)(gbase) + (voff)[_i]), (LAS unsigned*)(lds + (bufoff) + ldsw + _i * 8192), 16, 0, 0); } while (0)
#define PG8_LDA(dst, b, h) do { _Pragma("unroll") for (int m = 0; m < 4; ++m) _Pragma("unroll") for (int k = 0; k < 2; ++k) dst[m][k] = *(const LAS h8*)(lds + PG8_SA(b, h) + aoff + m * 2048 + k * 1024); } while (0)
#define PG8_LDB(dst, b, h) do { _Pragma("unroll") for (int n = 0; n < 2; ++n) _Pragma("unroll") for (int k = 0; k < 2; ++k) dst[n][k] = *(const LAS h8*)(lds + PG8_SB(b, h) + boff + n * 2048 + k * 1024); } while (0)
#define PG8_MMA(ai, bj, At, Bt) do { __builtin_amdgcn_s_setprio(1); _Pragma("unroll") for (int m = 0; m < 4; ++m) _Pragma("unroll") for (int n = 0; n < 2; ++n) _Pragma("unroll") for (int k = 0; k < 2; ++k) \
        acc[ai][bj][m][n] = __builtin_amdgcn_mfma_f32_16x16x32_f16(Bt[n][k], At[m][k], acc[ai][bj][m][n], 0, 0, 0); __builtin_amdgcn_s_setprio(0); } while (0)
#define PG8_WAIT_V(n) asm volatile("s_waitcnt vmcnt(" #n ")" ::: "memory")
#define PG8_WAIT_L(n) asm volatile("s_waitcnt lgkmcnt(" #n ")" ::: "memory")
#define PG8_BAR __builtin_amdgcn_s_barrier()
#define PG8_SCHED __builtin_amdgcn_sched_barrier(0)
    Unit cur, nxt; int ui = 0;
    if (!S.next(0, cur)) return;
    f32x4 acc[2][2][4][2];
#pragma unroll
    for (int a = 0; a < 2; ++a)
#pragma unroll
        for (int b = 0; b < 2; ++b)
#pragma unroll
            for (int m = 0; m < 4; ++m)
#pragma unroll
                for (int n = 0; n < 2; ++n) acc[a][b][m][n] = (f32x4){0.f, 0.f, 0.f, 0.f};
    h8 At[4][2], B0[2][2], B1[2][2];
    const char* cA = (const char*)g.A + (size_t)cur.pm * tstep; const char* cB = (const char*)g.Bt + (size_t)cur.pn * tstep;
    if constexpr (Epi::HAS_MID) E.begin(cur, ui, lds);
    if constexpr (SP2) {
        PG8_STAGE(PG8_SB(0, 0), cB, voffB); PG8_STAGE(PG8_SB(0, 1), cB + hstep, voffB); PG8_STAGE(PG8_SA(0, 0), cA, voffA); PG8_STAGE(PG8_SA(0, 1), cA + hstep, voffA);
        if (wr == 1) PG8_BAR;
        PG8_WAIT_V(2); PG8_BAR;
        PG8_STAGE(PG8_SB(1, 0), cB + kstep, voffB); PG8_STAGE(PG8_SA(1, 0), cA + kstep, voffA); PG8_STAGE(PG8_SB(1, 1), cB + hstep + kstep, voffB);
        PG8_WAIT_V(6); PG8_BAR;
    } else {
        PG8_STAGE(PG8_SB(0, 0), cB, voffB); PG8_STAGE(PG8_SA(0, 0), cA, voffA); PG8_STAGE(PG8_SB(0, 1), cB + hstep, voffB); PG8_STAGE(PG8_SA(0, 1), cA + hstep, voffA);
        if (wr == 1) PG8_BAR;
        PG8_WAIT_V(4); PG8_BAR;
        PG8_STAGE(PG8_SB(1, 0), cB + kstep, voffB); PG8_STAGE(PG8_SA(1, 0), cA + kstep, voffA); PG8_STAGE(PG8_SB(1, 1), cB + hstep + kstep, voffB);
        PG8_WAIT_V(6); PG8_BAR;
    }
    for (;;) {
        const bool has_next = S.next(ui + 1, nxt);
        const char* nA = has_next ? (const char*)g.A + (size_t)nxt.pm * tstep : cA; const char* nB = has_next ? (const char*)g.Bt + (size_t)nxt.pn * tstep : cB;
        for (int t = 0; t < nt; t += 2) {
            const bool last = (t == nt - 2);
            const char* a1 = cA + (size_t)(t + 1) * kstep;
            const char* a2 = last ? nA : cA + (size_t)(t + 2) * kstep; const char* b2 = last ? nB : cB + (size_t)(t + 2) * kstep;
            const char* a3 = a2 + kstep; const char* b3 = b2 + kstep;
            if constexpr (Epi::HAS_MID) { if (t == nt / 2) E.mid(acc, ui, wr, fr, lds); }
            if constexpr (SP2) {
            PG8_LDB(B0, 0, 0); PG8_LDB(B1, 0, 1); PG8_SCHED; PG8_LDA(At, 0, 0); PG8_STAGE(PG8_SA(1, 1), a1 + hstep, voffA);
            PG8_WAIT_V(8); PG8_WAIT_L(0); PG8_BAR; PG8_MMA(0, 0, At, B0); PG8_MMA(0, 1, At, B1); PG8_BAR; PG8_SCHED;
            PG8_LDA(At, 0, 1); PG8_STAGE(PG8_SB(0, 0), b2, voffB); PG8_STAGE(PG8_SB(0, 1), b2 + hstep, voffB); PG8_STAGE(PG8_SA(0, 0), a2, voffA);
            PG8_WAIT_V(8); PG8_WAIT_L(0); PG8_BAR; PG8_MMA(1, 0, At, B0); PG8_MMA(1, 1, At, B1); PG8_BAR; PG8_SCHED;
            PG8_LDB(B0, 1, 0); PG8_LDB(B1, 1, 1); PG8_SCHED; PG8_LDA(At, 1, 0); PG8_STAGE(PG8_SA(0, 1), a2 + hstep, voffA);
            PG8_WAIT_V(8); PG8_WAIT_L(0); PG8_BAR; PG8_MMA(0, 0, At, B0); PG8_MMA(0, 1, At, B1); PG8_BAR; PG8_SCHED;
            PG8_LDA(At, 1, 1); PG8_STAGE(PG8_SB(1, 0), b3, voffB); PG8_STAGE(PG8_SB(1, 1), b3 + hstep, voffB); PG8_STAGE(PG8_SA(1, 0), a3, voffA);
            PG8_WAIT_V(8); PG8_WAIT_L(0); PG8_BAR; PG8_MMA(1, 0, At, B0); PG8_MMA(1, 1, At, B1); PG8_BAR; PG8_SCHED;
            } else {
            PG8_LDB(B0, 0, 0); PG8_SCHED; PG8_LDA(At, 0, 0); PG8_STAGE(PG8_SA(1, 1), a1 + hstep, voffA);
            PG8_WAIT_L(8); PG8_BAR; PG8_WAIT_L(0); PG8_MMA(0, 0, At, B0); PG8_BAR; PG8_SCHED;
            PG8_LDB(B1, 0, 1); PG8_STAGE(PG8_SB(0, 0), b2, voffB);
            PG8_BAR; PG8_WAIT_L(0); PG8_MMA(0, 1, At, B1); PG8_BAR;
            PG8_LDA(At, 0, 1); PG8_STAGE(PG8_SA(0, 0), a2, voffA);
            PG8_BAR; PG8_WAIT_L(0); PG8_MMA(1, 0, At, B0); PG8_BAR; PG8_SCHED;
            PG8_STAGE(PG8_SB(0, 1), b2 + hstep, voffB);
            PG8_WAIT_V(6); PG8_BAR; PG8_MMA(1, 1, At, B1); PG8_BAR;
            PG8_LDB(B0, 1, 0); PG8_SCHED; PG8_LDA(At, 1, 0); PG8_STAGE(PG8_SA(0, 1), a2 + hstep, voffA);
            PG8_WAIT_L(8); PG8_BAR; PG8_WAIT_L(0); PG8_MMA(0, 0, At, B0); PG8_BAR; PG8_SCHED;
            PG8_LDB(B1, 1, 1); PG8_STAGE(PG8_SB(1, 0), b3, voffB);
            PG8_BAR; PG8_WAIT_L(0); PG8_MMA(0, 1, At, B1); PG8_BAR;
            PG8_LDA(At, 1, 1); PG8_STAGE(PG8_SA(1, 0), a3, voffA);
            PG8_BAR; PG8_WAIT_L(0); PG8_MMA(1, 0, At, B0); PG8_BAR; PG8_SCHED;
            PG8_STAGE(PG8_SB(1, 1), b3 + hstep, voffB);
            PG8_WAIT_V(6); PG8_BAR; PG8_MMA(1, 1, At, B1); PG8_BAR;
                    }
        }
        if constexpr (ALIGN_EPI) { if (wr == 0) PG8_BAR; }
        E(acc, cur, ui, wr, wc, fr, fq, lds);
        if constexpr (Epi::HAS_AFTER) E.after_unit(ui);
        if (!has_next) break;
#pragma unroll
        for (int a = 0; a < 2; ++a)
#pragma unroll
            for (int b = 0; b < 2; ++b)
#pragma unroll
                for (int m = 0; m < 4; ++m)
#pragma unroll
                    for (int n = 0; n < 2; ++n) acc[a][b][m][n] = (f32x4){0.f, 0.f, 0.f, 0.f};
        cur = nxt; cA = nA; cB = nB; ++ui;
        if constexpr (Epi::HAS_MID) E.begin(cur, ui, lds);
        if constexpr (ALIGN_EPI) { if (wr == 1) PG8_BAR; }
    }
    PG8_WAIT_V(0);
    if constexpr (!ALIGN_EPI) { if (wr == 0) PG8_BAR; }
    PG8_BAR;
#undef PG8_SA
#undef PG8_SB
#undef PG8_STAGE
#undef PG8_LDA
#undef PG8_LDB
#undef PG8_MMA
#undef PG8_WAIT_V
#undef PG8_WAIT_L
#undef PG8_BAR
#undef PG8_SCHED
}
}

struct EpiZ {
    static constexpr bool PERM = true, HAS_MID = false, HAS_AFTER = true;
    unsigned char* ws; float* WI; f32x2* VSTAT; unsigned* done5;
    __device__ __forceinline__ void begin(const pg8::Unit&, int, LAS unsigned char*) const {}
    __device__ __forceinline__ void mid(f32x4 (&)[2][2][4][2], int, int, int, LAS unsigned char*) const {}
    __device__ __forceinline__ void after_unit(int ui) const {
        if (ui == 5) {
            asm volatile("s_waitcnt vmcnt(0)" ::: "memory");
            __syncthreads();
            if (threadIdx.x == 0) {
                __builtin_amdgcn_fence(__ATOMIC_RELEASE, "agent");
                asm volatile("s_waitcnt vmcnt(0)" ::: "memory");
                __hip_atomic_fetch_add(done5, 1u, __ATOMIC_RELAXED, __HIP_MEMORY_SCOPE_AGENT);
            }
        }
    }
    __device__ __forceinline__ void operator()(const f32x4 (&acc)[2][2][4][2], const pg8::Unit& u, int, int wr, int wc, int fr, int fq, LAS unsigned char*) const {
        const int pn = u.pn;
        const int kind = pn < 16 ? 1 : ((pn < 24 || (pn >= 36 && pn < 44)) ? 2 : 0);
        const bool stats = (pn >= 8 && pn < 16);
        const bool blocked = pn < 24;
        size_t base; int ld, cofs;
        if (pn < 8) { base = WS_U; ld = 0; cofs = pn * 256; }
        else if (pn < 16) { base = WS_V; ld = 0; cofs = (pn - 8) * 256; }
        else if (pn < 24) { base = WS_GA; ld = 0; cofs = (pn - 16) * 256; }
        else if (pn < 32) { base = WS_QB; ld = 2048; cofs = (pn - 24) * 256; }
        else if (pn < 34) { base = WS_KB; ld = 512; cofs = (pn - 32) * 256; }
        else if (pn < 36) { base = WS_VV; ld = 512; cofs = (pn - 34) * 256; }
        else if (pn < 44) { base = WS_GB; ld = 2048; cofs = (pn - 36) * 256; }
        else if (pn < 60) { base = WS_QI; ld = 4096; cofs = (pn - 44) * 256; }
        else { base = WS_KI; ld = 128; cofs = 0; }
        _Float16* dst = (_Float16*)(ws + base);
        const int row0 = u.pm * 256 + wr * 64 + fr, cl = wc * 32 + 8 * fq;
#pragma unroll
        for (int ai = 0; ai < 2; ++ai)
#pragma unroll
            for (int m = 0; m < 4; ++m) {
                const int row = row0 + ai * 128 + m * 16;
                float s1 = 0.f, s2 = 0.f;
#pragma unroll
                for (int bj = 0; bj < 2; ++bj) {
                    float v[8];
#pragma unroll
                    for (int j = 0; j < 4; ++j) { v[j] = acc[ai][bj][m][0][j]; v[4 + j] = acc[ai][bj][m][1][j]; }
                    if (kind == 1) {
#pragma unroll
                        for (int j = 0; j < 8; ++j) v[j] = gelu_tanh(v[j]);
                    } else if (kind == 2) {
#pragma unroll
                        for (int j = 0; j < 8; ++j) v[j] = silu_f(v[j]);
                    }
                    if (stats) {
#pragma unroll
                        for (int j = 0; j < 8; ++j) { s1 += v[j]; s2 += v[j] * v[j]; }
                    }
                    u32x4 w;
                    if (pn == 34 || pn == 35) { w.x = cvtpk_bf16(v[0], v[1]); w.y = cvtpk_bf16(v[2], v[3]); w.z = cvtpk_bf16(v[4], v[5]); w.w = cvtpk_bf16(v[6], v[7]); }
                    else { w.x = pk_h2(v[0], v[1]); w.y = pk_h2(v[2], v[3]); w.z = pk_h2(v[4], v[5]); w.w = pk_h2(v[6], v[7]); }
                    if (blocked) {
                        const int head = (cofs >> 7) + bj;
                        *(u32x4*)(dst + ((size_t)((row >> 7) * 16 + head) * 128 + (row & 127)) * 128 + cl) = w;
                    } else if (pn < 60) {
                        *(u32x4*)(dst + (size_t)row * ld + cofs + bj * 128 + cl) = w;
                    } else if (bj == 0) {
                        *(u32x4*)(dst + (size_t)row * 128 + cl) = w;
                    } else if (wc == 0) {
                        float* wp = WI + (size_t)row * 32 + 8 * fq;
                        *(f32x4*)wp = (f32x4){v[0], v[1], v[2], v[3]} * 0.015625f;
                        *(f32x4*)(wp + 4) = (f32x4){v[4], v[5], v[6], v[7]} * 0.015625f;
                    }
                }
                if (stats) {
                    s1 += __shfl_xor(s1, 16); s1 += __shfl_xor(s1, 32);
                    s2 += __shfl_xor(s2, 16); s2 += __shfl_xor(s2, 32);
                    if (fq == 0) VSTAT[(size_t)row * 32 + (pn - 8) * 4 + wc] = (f32x2){s1, s2};
                }
            }
    }
};

struct EpiOut {
    static constexpr bool PERM = false, HAS_MID = true, HAS_AFTER = false;
    const float* x; float* out; const float* mod; const float* ssqa; const float* ssqb;
    __device__ __forceinline__ void begin(const pg8::Unit& u, int ui, LAS unsigned char* lds) const {
        const int tid = threadIdx.x;
        if (tid < 256) {
            const int row = u.pm * 256 + tid;
            const f32x4* pa = (const f32x4*)(ssqa + (size_t)row * 16);
            f32x4 a0 = pa[0], a1 = pa[1], a2 = pa[2], a3 = pa[3];
            const f32x4* pb = (const f32x4*)(ssqb + (size_t)row * 16);
            f32x4 b0 = pb[0], b1 = pb[1], b2 = pb[2], b3 = pb[3];
            b0 = (b0 + b1) + (b2 + b3);
            a0 = (a0 + a1) + (a2 + a3);
            const float sa = (a0[0] + a0[1]) + (a0[2] + a0[3]), sb = (b0[0] + b0[1]) + (b0[2] + b0[3]);
            const float ra = 1.0f / sqrtf(sa * (1.0f / 2048.0f) + EPS), rb = 1.0f / sqrtf(sb * (1.0f / 2048.0f) + EPS);
            LAS f32x2* F = (LAS f32x2*)(lds + LDS_X) + (ui & 1) * 256;
            F[tid] = (f32x2){ra / rb, rb};
        }
    }
    __device__ __forceinline__ void mid(f32x4 (&acc)[2][2][4][2], int ui, int wr, int fr, LAS unsigned char* lds) const {
        const LAS f32x2* F = (const LAS f32x2*)(lds + LDS_X) + (ui & 1) * 256;
#pragma unroll
        for (int ai = 0; ai < 2; ++ai)
#pragma unroll
            for (int m = 0; m < 4; ++m) {
                const float r = F[ai * 128 + wr * 64 + m * 16 + fr].x;
#pragma unroll
                for (int bj = 0; bj < 2; ++bj)
#pragma unroll
                    for (int n = 0; n < 2; ++n) acc[ai][bj][m][n] = acc[ai][bj][m][n] * r;
            }
    }
    __device__ __forceinline__ void operator()(const f32x4 (&acc)[2][2][4][2], const pg8::Unit& u, int ui, int wr, int wc, int fr, int fq, LAS unsigned char* lds) const {
        const LAS f32x2* F = (const LAS f32x2*)(lds + LDS_X) + (ui & 1) * 256;
        const int b = u.pm >> 3;
        const int col0 = u.pn * 256 + wc * 32 + 4 * fq;
        f32x4 gv[2][2];
#pragma unroll
        for (int bj = 0; bj < 2; ++bj)
#pragma unroll
            for (int n = 0; n < 2; ++n) gv[bj][n] = *(const f32x4*)(mod + (size_t)b * 3 * DM + 2 * DM + col0 + bj * 128 + n * 16);
        f32x4 xa[2][2], xb[2][2];
#define EPO_LOAD(dst, g_) do { const int rl_ = ((g_) >> 2) * 128 + wr * 64 + ((g_) & 3) * 16 + fr; const size_t off_ = (size_t)(u.pm * 256 + rl_) * DM + col0; \
        _Pragma("unroll") for (int bj = 0; bj < 2; ++bj) _Pragma("unroll") for (int n = 0; n < 2; ++n) dst[bj][n] = *(const f32x4*)(x + off_ + bj * 128 + n * 16); } while (0)
#define EPO_STORE(src, g_) do { const int rl_ = ((g_) >> 2) * 128 + wr * 64 + ((g_) & 3) * 16 + fr; const size_t off_ = (size_t)(u.pm * 256 + rl_) * DM + col0; const float rb_ = F[rl_].y; \
        _Pragma("unroll") for (int bj = 0; bj < 2; ++bj) _Pragma("unroll") for (int n = 0; n < 2; ++n) \
            __builtin_nontemporal_store(src[bj][n] + gv[bj][n] * (acc[(g_) >> 2][bj][(g_) & 3][n] * rb_), (f32x4*)(out + off_ + bj * 128 + n * 16)); } while (0)
        EPO_LOAD(xa, 0);
        EPO_LOAD(xb, 1); EPO_STORE(xa, 0); asm volatile("" ::: "memory");
        EPO_LOAD(xa, 2); EPO_STORE(xb, 1); asm volatile("" ::: "memory");
        EPO_LOAD(xb, 3); EPO_STORE(xa, 2); asm volatile("" ::: "memory");
        EPO_LOAD(xa, 4); EPO_STORE(xb, 3); asm volatile("" ::: "memory");
        EPO_LOAD(xb, 5); EPO_STORE(xa, 4); asm volatile("" ::: "memory");
        EPO_LOAD(xa, 6); EPO_STORE(xb, 5); asm volatile("" ::: "memory");
        EPO_LOAD(xb, 7); EPO_STORE(xa, 6); asm volatile("" ::: "memory");
        EPO_STORE(xb, 7);
#undef EPO_LOAD
#undef EPO_STORE
    }
};


namespace att {
typedef short bf16x8 __attribute__((ext_vector_type(8)));
typedef short s16x4 __attribute__((ext_vector_type(4)));
#define ATT_KSWZ(row, colB) ((row) * 256 + ((colB) ^ (((row) & 7) << 4)))
#define ATT_SBAR() __builtin_amdgcn_sched_barrier(0)
__device__ __forceinline__ int crow(int r, int hi) { return (r & 3) + 8 * (r >> 2) + 4 * hi; }
__device__ __forceinline__ int v_st(int k, int c) { const int kk = (k & ~0xC) | ((k & 4) << 1) | ((k & 8) >> 1); return ((kk >> 3) * 4 + (c >> 5)) * 512 + ((kk & 7) * 32 + (c & 31)) * 2; }
__device__ __forceinline__ int v_rd_base(int lane) { return ((lane & 3) << 3) | (((lane >> 2) & 3) << 6) | (((lane >> 4) & 1) << 5) | (((lane >> 5) & 1) << 8); }
constexpr int v_rd_off(int d0, int ks, int half) { return d0 * 512 + ks * 4096 + half * 2048; }
template <int OFF> __device__ __forceinline__ s16x4 tr_read(int vb) {
    s16x4 r; asm volatile("ds_read_b64_tr_b16 %0, %1 offset:%2" : "=&v"(r) : "v"(vb), "i"(OFF) : "memory"); return r;
}
template <int D0> __device__ __forceinline__ void pv_one(f32x16& od, int vb, bf16x8 pa0, bf16x8 pa1, bf16x8 pa2, bf16x8 pa3) {
    const s16x4 l0 = tr_read<v_rd_off(D0, 0, 0)>(vb), h0 = tr_read<v_rd_off(D0, 0, 1)>(vb), l1 = tr_read<v_rd_off(D0, 1, 0)>(vb), h1 = tr_read<v_rd_off(D0, 1, 1)>(vb);
    const s16x4 l2 = tr_read<v_rd_off(D0, 2, 0)>(vb), h2 = tr_read<v_rd_off(D0, 2, 1)>(vb), l3 = tr_read<v_rd_off(D0, 3, 0)>(vb), h3 = tr_read<v_rd_off(D0, 3, 1)>(vb);
    asm volatile("s_waitcnt lgkmcnt(0)" ::: "memory"); ATT_SBAR();
#define ATT_PK(L, H) (bf16x8){L[0], L[1], L[2], L[3], H[0], H[1], H[2], H[3]}
    od = __builtin_amdgcn_mfma_f32_32x32x16_bf16(pa0, ATT_PK(l0, h0), od, 0, 0, 0);
    od = __builtin_amdgcn_mfma_f32_32x32x16_bf16(pa1, ATT_PK(l1, h1), od, 0, 0, 0);
    od = __builtin_amdgcn_mfma_f32_32x32x16_bf16(pa2, ATT_PK(l2, h2), od, 0, 0, 0);
    od = __builtin_amdgcn_mfma_f32_32x32x16_bf16(pa3, ATT_PK(l3, h3), od, 0, 0, 0);
#undef ATT_PK
}
__device__ __forceinline__ void qkt(f32x16& p0, f32x16& p1, const LAS unsigned char* Ks, const h8* qr, int r32, int hi) {
#pragma unroll
    for (int r = 0; r < 16; ++r) { p0[r] = 0.f; p1[r] = 0.f; }
#pragma unroll
    for (int d0 = 0; d0 < 8; ++d0) { const int cb = (d0 * 16 + hi * 8) * 2;
        const h8 b0 = *(const LAS h8*)(Ks + ATT_KSWZ(r32, cb));
        const h8 b1 = *(const LAS h8*)(Ks + ATT_KSWZ(32 + r32, cb));
        p0 = __builtin_amdgcn_mfma_f32_32x32x16_f16(b0, qr[d0], p0, 0, 0, 0);
        p1 = __builtin_amdgcn_mfma_f32_32x32x16_f16(b1, qr[d0], p1, 0, 0, 0); }
}
constexpr int L_V = 0, L_K = 32768, L_MSK = 65536, L_LI = L_MSK + 64 * 66 * 4, L_DT = L_LI + 1024, L_BK = L_DT + 4096, L_GQK = L_BK + 512, L_RB = L_GQK + 512, L_END = L_RB + 2048;
}


#define XB_TMO      128
#define XB_XCNT(j)  (256  + 64 * (j))
#define XB_XSUB(j)  (1280 + 64 * (j))
#define XB_XGEN(j)  (2304 + 64 * (j))
#define XB_TOP      3328
#define XB_TOPGEN   3392
#define XCD_BAR_WORDS 3456
#define XB_SPIN_CAP (1u << 18)
__device__ __forceinline__ unsigned xb_ld(unsigned* p)              { return __hip_atomic_load(p, __ATOMIC_RELAXED, __HIP_MEMORY_SCOPE_AGENT); }
__device__ __forceinline__ unsigned xb_add(unsigned* p, unsigned v) { return __hip_atomic_fetch_add(p, v, __ATOMIC_RELAXED, __HIP_MEMORY_SCOPE_AGENT); }
__device__ __forceinline__ unsigned xb_xcc_id() { return (unsigned)__builtin_amdgcn_s_getreg((3 << 11) | 20) & 0xFu; }
#define XB_SPIN(cond, bar) do { unsigned _sp = 0; while (cond) { __builtin_amdgcn_s_sleep(1); \
    if ((++_sp & 255u) == 0u) { if (xb_ld(&(bar)[XB_TMO])) break; if (_sp > XB_SPIN_CAP) { atomicAdd(&(bar)[XB_TMO], 1u); break; } } } } while (0)
struct XcdBarrier { unsigned* bar; unsigned x; volatile LAS unsigned* st; };
__device__ __forceinline__ XcdBarrier xcd_barrier_post(unsigned* bar, volatile LAS unsigned* st) {
    XcdBarrier b; b.bar = bar; b.x = xb_xcc_id(); b.st = st;
    if (threadIdx.x == 0) (void)xb_add(&bar[XB_XCNT(b.x)], 1u);
    return b;
}
__device__ __forceinline__ void xcd_barrier_complete(unsigned* bar, unsigned x, unsigned& nloc, unsigned& nx) {
    const unsigned G = gridDim.x * gridDim.y * gridDim.z;
    unsigned sum, cnt, mine, sp = 0u;
    for (;;) {
        sum = 0u; cnt = 0u; mine = 0u;
#pragma unroll
        for (unsigned j = 0; j < 16; ++j) { const unsigned c = xb_ld(&bar[XB_XCNT(j)]); sum += c; cnt += (c > 0u) ? 1u : 0u; mine = (j == x) ? c : mine; }
        if (sum == G) break;
        __builtin_amdgcn_s_sleep(1);
        if ((++sp & 255u) == 0u) { if (xb_ld(&bar[XB_TMO])) break; if (sp > XB_SPIN_CAP) { atomicAdd(&bar[XB_TMO], 1u); break; } }
    }
    nloc = mine > 0u ? mine : 1u; nx = cnt > 0u ? cnt : 1u;
}
__device__ __forceinline__ void xcd_barrier(const XcdBarrier& b) {
    asm volatile("s_waitcnt vmcnt(0)" ::: "memory");
    __syncthreads();
    if (threadIdx.x == 0) {
        unsigned* bar = b.bar;
        __builtin_amdgcn_s_waitcnt(0);
        unsigned nloc = b.st[0], nx = b.st[1];
        if (nloc == 0u) { xcd_barrier_complete(bar, b.x, nloc, nx); b.st[0] = nloc; b.st[1] = nx; }
        const unsigned old = xb_add(&bar[XB_XSUB(b.x)], 1u);
        const unsigned gen = old / nloc;
        if (old + 1u == (gen + 1u) * nloc) {
            __builtin_amdgcn_fence(__ATOMIC_RELEASE, "agent");
            asm volatile("s_waitcnt vmcnt(0)" ::: "memory");
            const unsigned og = xb_add(&bar[XB_TOP], 1u);
            const unsigned tg = og / nx;
            if (og + 1u == (tg + 1u) * nx) xb_add(&bar[XB_TOPGEN], 1u);
            else XB_SPIN(xb_ld(&bar[XB_TOPGEN]) == tg, bar);
            __builtin_amdgcn_fence(__ATOMIC_ACQUIRE, "agent");
            xb_add(&bar[XB_XGEN(b.x)], 1u);
            asm volatile("s_waitcnt vmcnt(0)" ::: "memory");
        } else {
            XB_SPIN(xb_ld(&bar[XB_XGEN(b.x)]) == gen, bar);
            __builtin_amdgcn_fence(__ATOMIC_ACQUIRE, "agent");
            asm volatile("s_waitcnt vmcnt(0)" ::: "memory");
        }
    }
    __syncthreads();
}

__device__ __forceinline__ void topk_select(unsigned (&uk)[32], int t, unsigned* mrow, int lane, LAS unsigned* cb) {
    if (t + 1 <= TOPK) {
#pragma unroll 4
        for (int i = 0; i < 32; ++i) {
            const unsigned long long m = __ballot(64 * i + lane <= t);
            if (lane == 0) *(u32x2*)(mrow + 2 * i) = (u32x2){(unsigned)m, (unsigned)(m >> 32)};
        }
        return;
    }
#define TK_COUNT(cand_, cnt_) do { int c0_ = 0, c1_ = 0; \
        _Pragma("unroll") for (int i = 0; i < 32; i += 2) { c0_ += (uk[i] >= (cand_)) ? 1 : 0; c1_ += (uk[i + 1] >= (cand_)) ? 1 : 0; } \
        int c_ = c0_ + c1_; \
        c_ += __builtin_amdgcn_update_dpp(0, c_, 0xB1, 0xF, 0xF, false); c_ += __builtin_amdgcn_update_dpp(0, c_, 0x4E, 0xF, 0xF, false); \
        c_ += __builtin_amdgcn_update_dpp(0, c_, 0x141, 0xF, 0xF, false); c_ += __builtin_amdgcn_update_dpp(0, c_, 0x140, 0xF, 0xF, false); \
        cnt_ = __builtin_amdgcn_readlane(c_, 0) + __builtin_amdgcn_readlane(c_, 16) + __builtin_amdgcn_readlane(c_, 32) + __builtin_amdgcn_readlane(c_, 48); } while (0)
    unsigned M = 0u;
#pragma unroll
    for (int i = 0; i < 32; ++i) M = uk[i] > M ? uk[i] : M;
#pragma unroll
    for (int o = 1; o < 64; o <<= 1) { const unsigned v = (unsigned)__shfl_xor((int)M, o); M = v > M ? v : M; }
    M = (unsigned)__builtin_amdgcn_readfirstlane((int)M);
    unsigned T = 0u; bool exact = false; int bit = 31;
    int cnt_lo = 1 << 30, cnt_hi = 0;
#pragma unroll 1
    for (int nb = 8; nb >= 5; --nb) {
        const unsigned P = M & ~((1u << (32 - nb)) - 1u);
        int cnt; TK_COUNT(P, cnt);
        if (cnt >= TOPK) { T = P; bit = 31 - nb; cnt_lo = cnt; exact = (cnt == TOPK); break; }
    }
#pragma unroll 1
    for (; bit >= 0 && !exact && cnt_lo - cnt_hi > 64; --bit) {
        const unsigned cand = T | (1u << bit);
        int cnt; TK_COUNT(cand, cnt);
        if (cnt >= TOPK) { T = cand; cnt_lo = cnt; } else cnt_hi = cnt;
        if (cnt == TOPK) exact = true;
    }
#undef TK_COUNT
    if (!exact && bit >= 0) {
        const unsigned top = T >> (bit + 1);
        int base = 0;
#pragma unroll
        for (int i = 0; i < 32; ++i) {
            const bool al = (uk[i] >> (bit + 1)) == top;
            const unsigned long long m = __ballot(al);
            if (m) {
                if (al) cb[base + (int)__builtin_amdgcn_mbcnt_hi((unsigned)(m >> 32), __builtin_amdgcn_mbcnt_lo((unsigned)m, 0u))] = uk[i];
                base += __popcll(m);
            }
        }
        asm volatile("s_waitcnt lgkmcnt(0)" ::: "memory");
        const unsigned key = (lane < base) ? cb[lane] : 0u;
        const int r = TOPK - cnt_hi;
#pragma unroll 1
        for (int b = bit; b >= 0; --b) {
            const unsigned cand = T | (1u << b);
            if (__popcll(__ballot(key >= cand)) >= r) T = cand;
        }
        exact = (cnt_hi + __popcll(__ballot(key >= T)) == TOPK);
    }
    asm volatile("" : "+v"(T));
    if (exact) {
#pragma unroll
        for (int i = 0; i < 32; ++i) {
            const unsigned long long m = __ballot(uk[i] >= T);
            if (lane == 0) *(u32x2*)(mrow + 2 * i) = (u32x2){(unsigned)m, (unsigned)(m >> 32)};
        }
    } else {
        int cgt = 0;
#pragma unroll
        for (int i = 0; i < 32; ++i) cgt += __popcll(__ballot(uk[i] > T));
        int need = TOPK - cgt;
#pragma unroll 1
        for (int i = 0; i < 32; ++i) {
            unsigned ui = 0u;
#pragma unroll
            for (int q = 0; q < 32; ++q) ui = (q == i) ? uk[q] : ui;
            const unsigned long long gt = __ballot(ui > T);
            unsigned long long eq = __ballot(ui == T);
            int ce = __popcll(eq);
            while (ce > need) { eq &= ~(1ull << (63 - __clzll(eq))); --ce; }
            need -= ce;
            const unsigned long long m = gt | eq;
            if (lane == 0) *(u32x2*)(mrow + 2 * i) = (u32x2){(unsigned)m, (unsigned)(m >> 32)};
        }
    }
}

struct GmlpPar { const float* ln_v_g; const float* ln_v_b; const float* b_s; const float* out_norm_a_g; };
__device__ __forceinline__ void gmlp_unit(int un, const _Float16* UBl, const _Float16* VBl, const _Float16* GABl, const _Float16* WS16, const f32x2* VSTAT, _Float16* Y, float* SSQA,
                                          const GmlpPar a, LAS unsigned char* lds, int tid, int lane, int wave) {
    LAS _Float16* vnT = (LAS _Float16*)lds;
    LAS float* sp = (LAS float*)(lds + 34816);
    LAS float* mu = (LAS float*)(lds + 34816 + 67584);
    const int r32 = lane & 31, hi = lane >> 5, tb = wave >> 1, chalf = wave & 1;
    const int hh = un & 15, nchk = (un >> 4) & 15, b = un >> 8;
    const int tok0 = b * SEQ + nchk * 128, c0 = hh * 128;
    const size_t tile = (size_t)((b * 16 + nchk) * 16 + hh) * 16384;
    const int tq = tid >> 5, cq = tid & 31;
    const int stt = tid >> 2, spart = tid & 3;
    f32x2 stv[8];
    { const f32x2* vp = VSTAT + (size_t)(tok0 + stt) * 32 + spart * 8;
#pragma unroll
      for (int q = 0; q < 8; ++q) stv[q] = vp[q]; }
    const int vcc = (tid & 15) * 8;
    h8 gvv[4];
#pragma unroll
    for (int p = 0; p < 4; ++p) gvv[p] = __builtin_nontemporal_load((const h8*)(VBl + tile + ((p * 512 + tid) >> 4) * 128 + vcc));
    const f32x4 lg0 = *(const f32x4*)(a.ln_v_g + c0 + vcc), lg1 = *(const f32x4*)(a.ln_v_g + c0 + vcc + 4);
    const f32x4 lb0 = *(const f32x4*)(a.ln_v_b + c0 + vcc), lb1 = *(const f32x4*)(a.ln_v_b + c0 + vcc + 4);
    h8 wfr[8];
    { const _Float16* wp = WS16 + ((size_t)hh * 128 + 32 * tb + r32) * 128 + 8 * hi;
#pragma unroll
      for (int kk = 0; kk < 8; ++kk) wfr[kk] = (kk <= 2 * tb + 1) ? *(const h8*)(wp + 16 * kk) : (h8){0, 0, 0, 0, 0, 0, 0, 0}; }
    h4 gu[8], gg[8]; float bsv[8];
#pragma unroll
    for (int i = 0; i < 8; ++i) { const int tt = tq * 8 + i; gu[i] = __builtin_nontemporal_load((const h4*)(UBl + tile + tt * 128 + 4 * cq)); gg[i] = __builtin_nontemporal_load((const h4*)(GABl + tile + tt * 128 + 4 * cq)); bsv[i] = a.b_s[hh * 128 + tt]; }
    const f32x4 og = *(const f32x4*)(a.out_norm_a_g + c0 + 4 * cq);
    __syncthreads();
    {
        float s1 = 0.f, s2 = 0.f;
#pragma unroll
        for (int q = 0; q < 8; ++q) { s1 += stv[q].x; s2 += stv[q].y; }
        s1 += __shfl_xor(s1, 1); s1 += __shfl_xor(s1, 2); s2 += __shfl_xor(s2, 1); s2 += __shfl_xor(s2, 2);
        const float mean = s1 * (1.0f / 2048.0f), var = fmaxf(s2 * (1.0f / 2048.0f) - mean * mean, 0.f);
        if (spart == 0) { mu[stt] = mean; mu[128 + stt] = 1.0f / sqrtf(var + EPS); }
    }
    __syncthreads();
#pragma unroll
    for (int p = 0; p < 4; ++p) {
        const int s_ = (p * 512 + tid) >> 4;
        const float m_ = mu[s_], r_ = mu[128 + s_];
#pragma unroll
        for (int q = 0; q < 4; ++q) {
            vnT[(vcc + q) * 136 + s_] = (_Float16)(((float)gvv[p][q] - m_) * r_ * lg0[q] + lb0[q]);
            vnT[(vcc + 4 + q) * 136 + s_] = (_Float16)(((float)gvv[p][4 + q] - m_) * r_ * lg1[q] + lb1[q]);
        }
    }
    __syncthreads();
    {
        f32x16 acc0, acc1;
#pragma unroll
        for (int r = 0; r < 16; ++r) { acc0[r] = 0.f; acc1[r] = 0.f; }
        const LAS _Float16* bp = vnT + (chalf * 64 + r32) * 136 + 8 * hi;
#pragma unroll
        for (int kk = 0; kk < 8; ++kk) {
            if (kk <= 2 * tb + 1) {
                const h8 b0 = *(const LAS h8*)(bp + 16 * kk), b1 = *(const LAS h8*)(bp + 32 * 136 + 16 * kk);
                acc0 = __builtin_amdgcn_mfma_f32_32x32x16_f16(wfr[kk], b0, acc0, 0, 0, 0);
                acc1 = __builtin_amdgcn_mfma_f32_32x32x16_f16(wfr[kk], b1, acc1, 0, 0, 0);
            }
        }
#pragma unroll
        for (int r = 0; r < 16; ++r) {
            const int tt = 32 * tb + (r & 3) + 8 * (r >> 2) + 4 * hi;
            sp[tt * 132 + chalf * 64 + r32] = acc0[r]; sp[tt * 132 + chalf * 64 + 32 + r32] = acc1[r];
        }
    }
    __syncthreads();
#pragma unroll
    for (int i = 0; i < 8; ++i) {
        const int tt = tq * 8 + i; const size_t row = (size_t)(tok0 + tt);
        const f32x4 spv = *(const LAS f32x4*)(sp + tt * 132 + 4 * cq);
        f32x4 y; float ss = 0.f;
#pragma unroll
        for (int q = 0; q < 4; ++q) { y[q] = (float)gu[i][q] * (spv[q] + bsv[i]); ss += y[q] * y[q]; y[q] = y[q] * og[q] * (float)gg[i][q]; }
#pragma unroll
        for (int o = 1; o < 32; o <<= 1) ss += __shfl_xor(ss, o);
        if (cq == 0) SSQA[row * 16 + hh] = ss;
        u32x2 w; w.x = pk_h2(y[0], y[1]); w.y = pk_h2(y[2], y[3]);
        *(u32x2*)(Y + row * DM + c0 + 4 * cq) = w;
    }
}

struct Args {
    const float* x; const float* c; const float* w_ada; const float* b_ada; const float* norm_g; const float* w_in; const float* ln_v_g; const float* ln_v_b;
    const float* w_s; const float* b_s; const float* q_norm_g; const float* k_norm_g; const float* rel_bias; const float* out_norm_a_g; const float* out_norm_b_g; const float* w_out;
    float* out; unsigned char* ws; int ph_lo, ph_hi;
};

__device__ __forceinline__ void p0_transpose_item(const float* W, int K, int N, _Float16* WT, LAS float* scr, int kb, int nb, int lane) {
    const int k0 = 64 * kb, n0 = 32 * nb;
    const int c = lane & 7;
    if (n0 >= N) {
#pragma unroll
        for (int j = 0; j < 4; ++j) { const int n = (lane >> 3) + 8 * j; *(u32x4*)(WT + (size_t)(n0 + n) * K + k0 + 8 * c) = (u32x4){0u, 0u, 0u, 0u}; }
        return;
    }
#pragma unroll 8
    for (int i = 0; i < 32; ++i) { const int kk = 2 * i + (lane >> 5); scr[kk * 33 + (lane & 31)] = __builtin_nontemporal_load(W + (size_t)(k0 + kk) * N + n0 + (lane & 31)); }
    asm volatile("s_waitcnt lgkmcnt(0)" ::: "memory");
#pragma unroll
    for (int j = 0; j < 4; ++j) { const int n = (lane >> 3) + 8 * j; const LAS float* s = scr + (8 * c) * 33 + n;
        u32x4 o; o.x = pk_h2(s[0 * 33], s[1 * 33]); o.y = pk_h2(s[2 * 33], s[3 * 33]); o.z = pk_h2(s[4 * 33], s[5 * 33]); o.w = pk_h2(s[6 * 33], s[7 * 33]);
        *(u32x4*)(WT + (size_t)(n0 + n) * K + k0 + 8 * c) = o; }
    asm volatile("s_waitcnt lgkmcnt(0)" ::: "memory");
}

__global__ void __launch_bounds__(512, 2) fwd_kernel(Args a) {
    extern __shared__ __attribute__((aligned(16))) unsigned char lds_raw[];
    LAS unsigned char* lds = (LAS unsigned char*)lds_raw;
    cg::grid_group grid = cg::this_grid();
    const int tid = threadIdx.x, lane = tid & 63, wave = __builtin_amdgcn_readfirstlane(tid >> 6);
    const int G = gridDim.x, blk = blockIdx.x;
    const int gw = blk * 8 + wave, NGW = G * 8;
    unsigned char* ws = a.ws;
    _Float16* WTin = (_Float16*)(ws + WS_WTIN); _Float16* WTout = (_Float16*)(ws + WS_WTOUT);
    _Float16* H = (_Float16*)(ws + WS_H); _Float16* Y = (_Float16*)(ws + WS_Y);
    const _Float16* UBl = (const _Float16*)(ws + WS_U); const _Float16* VBl = (const _Float16*)(ws + WS_V); const _Float16* GABl = (const _Float16*)(ws + WS_GA);
    const _Float16* QBm = (const _Float16*)(ws + WS_QB); const _Float16* KBm = (const _Float16*)(ws + WS_KB); const _Float16* VVm = (const _Float16*)(ws + WS_VV);
    const _Float16* GBm = (const _Float16*)(ws + WS_GB); const _Float16* QIm = (const _Float16*)(ws + WS_QI); const _Float16* KIm = (const _Float16*)(ws + WS_KI);
    float* WI = (float*)(ws + WS_WI); float* MODP = (float*)(ws + WS_MODP); float* MOD = (float*)(ws + WS_MOD);
    f32x2* VSTAT = (f32x2*)(ws + WS_VSTAT); unsigned* MASK = (unsigned*)(ws + WS_MASK);
    float* SSQA = (float*)(ws + WS_SSQA); float* SSQB = (float*)(ws + WS_SSQB);
    const int lo = a.ph_lo, hi = a.ph_hi;
    const int gmlp_pre = (G == 256) ? 768 : 0;
#ifndef PHMASK
#define PHMASK 63
#endif
#define IN(k) (((PHMASK >> (k)) & 1) && lo <= (k) && (k) < hi)
    volatile LAS unsigned* xbw = (volatile LAS unsigned*)(lds + LDS_X + 8192);
    if (tid < 4) xbw[tid] = 0u;
    __syncthreads();
    const XcdBarrier xbar = xcd_barrier_post((unsigned*)ws, xbw);
    if (a.ph_lo < 0) grid.sync();
#define SEAM(k) do { if (IN(k) && IN((k) + 1)) xcd_barrier(xbar); } while (0)

    if (IN(0)) {
        LAS float* sc = (LAS float*)lds;
        for (int i = tid; i < NB * DM; i += 512) sc[i] = silu_f(a.c[i]);
        __syncthreads();
        LAS float* scr = (LAS float*)(lds + 65536 + wave * 8704);
        constexpr int N_ADA = 96 * KSPLIT;
        constexpr int N_TIN = 64 * (NZP / 32), N_TOUT = 64 * (DM / 32), N_WS = 16 * 128;
        for (int it = gw; it < N_ADA + N_TIN + N_TOUT + N_WS; it += NGW) {
            if (it < N_ADA) {
                const int jb = it % 96, ks = it / 96, j0 = jb * 128 + 2 * lane, k0 = ks * (DM / KSPLIT);
                f32x2 acc[NB];
#pragma unroll
                for (int b = 0; b < NB; ++b) acc[b] = (f32x2){0.f, 0.f};
                const float* wp = a.w_ada + (size_t)k0 * (3 * DM) + j0;
#pragma unroll 8
                for (int k = 0; k < DM / KSPLIT; ++k) {
                    const f32x2 w = __builtin_nontemporal_load((const f32x2*)(wp + (size_t)k * (3 * DM)));
#pragma unroll
                    for (int b = 0; b < NB; ++b) acc[b] += w * sc[b * DM + k0 + k];
                }
#pragma unroll
                for (int b = 0; b < NB; ++b) *(f32x2*)(MODP + ((size_t)ks * NB + b) * (3 * DM) + j0) = acc[b];
            } else if (it < N_ADA + N_TIN) {
                const int r = it - N_ADA; p0_transpose_item(a.w_in, DM, NZ, WTin, scr, r / (NZP / 32), r % (NZP / 32), lane);
            } else if (it < N_ADA + N_TIN + N_TOUT) {
                const int r = it - N_ADA - N_TIN; p0_transpose_item(a.w_out, DM, DM, WTout, scr, r / (DM / 32), r % (DM / 32), lane);
            } else {
                const int r = it - N_ADA - N_TIN - N_TOUT, tt = r & 127;
                const f32x2 w = *(const f32x2*)(a.w_s + (size_t)r * 128 + 2 * lane);
                *(unsigned*)((_Float16*)(ws + WS_WS16) + (size_t)r * 128 + 2 * lane) = pk_h2(2 * lane <= tt ? w.x : 0.f, 2 * lane + 1 <= tt ? w.y : 0.f);
            }
        }
    }
    SEAM(0);

    if (IN(1)) {
        {
            const int per = (NB * 3 * DM) / G;
            for (int i = tid; i < per; i += 512) {
                const int e = blk * per + i, b = e / (3 * DM), j = e % (3 * DM);
                float s = a.b_ada[j];
                for (int ks = 0; ks < KSPLIT; ++ks) s += MODP[((size_t)ks * NB + b) * (3 * DM) + j];
                MOD[e] = s;
            }
        }
        const int rows_per = NT / G;
        const int b = (blk * rows_per) / SEQ;
        LAS float* sh = (LAS float*)lds;
#pragma unroll 1
        for (int j4 = tid; j4 < 2 * DM / 4; j4 += 512) {
            f32x4 pv[KSPLIT];
#pragma unroll
            for (int ks = 0; ks < KSPLIT; ++ks) pv[ks] = *(const f32x4*)(MODP + ((size_t)ks * NB + b) * (3 * DM) + 4 * j4);
            f32x4 s4 = *(const f32x4*)(a.b_ada + 4 * j4);
#pragma unroll
            for (int ks = 0; ks < KSPLIT; ++ks) s4 += pv[ks];
            if (4 * j4 >= DM) s4 = (s4 + 1.0f) * *(const f32x4*)(a.norm_g + 4 * j4 - DM);
            *(LAS f32x4*)(sh + 4 * j4) = s4;
        }
        __syncthreads();
#pragma unroll 1
        for (int r = wave; r < rows_per; r += 8) {
            const int row = blk * rows_per + r;
            asm volatile("" ::: "memory");
            const f32x4* xr = (const f32x4*)(a.x + (size_t)row * DM) + lane;
            f32x4 v[16]; float ss = 0.f;
#pragma unroll
            for (int j = 0; j < 16; ++j) { v[j] = __builtin_nontemporal_load(xr + 64 * j); ss += (v[j].x * v[j].x + v[j].y * v[j].y) + (v[j].z * v[j].z + v[j].w * v[j].w); }
            const float rstd = 1.0f / sqrtf(wave_sum(ss) * (1.0f / DM) + EPS);
            u32x2* o8 = (u32x2*)(H + (size_t)row * DM) + lane;
#pragma unroll
            for (int j = 0; j < 16; ++j) {
                const int col = 256 * j + 4 * lane;
                const f32x4 sf = *(const LAS f32x4*)(sh + col), sc = *(const LAS f32x4*)(sh + DM + col);
                const f32x4 hv = v[j] * rstd * sc + sf;
                u32x2 w; w.x = pk_h2(hv.x, hv.y); w.y = pk_h2(hv.z, hv.w); o8[64 * j] = w;
                if ((j & 3) == 3) asm volatile("" ::: "memory");
            }
        }
    }
    SEAM(1);

    if (IN(2)) {
        pg8::Gemm g{H, WTin, NT, NZP, DM}; pg8::StaticOrder S; S.init(NT, NZP, G, blk);
        unsigned* done5 = (unsigned*)ws + XCD_BAR_WORDS;
        EpiZ E{ws, WI, VSTAT, done5};
        pg8::gemm_phase<EpiZ>(lds, g, S, E);
        if (gmlp_pre > 0 && blk >= G - gmlp_pre / 8) {
            if (tid == 0) {
                unsigned sp_ = 0;
                while (__hip_atomic_load(done5, __ATOMIC_RELAXED, __HIP_MEMORY_SCOPE_AGENT) < (unsigned)G) { __builtin_amdgcn_s_sleep(2); if (++sp_ > (1u << 22)) break; }
                __builtin_amdgcn_fence(__ATOMIC_ACQUIRE, "agent");
                asm volatile("s_waitcnt vmcnt(0)" ::: "memory");
            }
            __syncthreads();
            const GmlpPar gp{a.ln_v_g, a.ln_v_b, a.b_s, a.out_norm_a_g};
            const int u0 = (blk - (G - gmlp_pre / 8)) * 8;
            for (int k = 0; k < 8; ++k) gmlp_unit(u0 + k, UBl, VBl, GABl, (const _Float16*)(ws + WS_WS16), VSTAT, Y, SSQA, gp, lds, tid, lane, wave);
        }
    }
    SEAM(2);

    if (IN(3)) {
        {
            _Float16* KNw = (_Float16*)(ws + WS_KN);
            constexpr int KN_IT = NT / 2048;
            int lane_k = lane; asm volatile("" : "+v"(lane_k));
            h8 kv[KN_IT];
#pragma unroll
            for (int i = 0; i < KN_IT; ++i) { const int tok = gw + i * NGW; kv[i] = (tok < NT) ? __builtin_nontemporal_load((const h8*)(KBm + (size_t)tok * 512 + 8 * lane_k)) : (h8){0, 0, 0, 0, 0, 0, 0, 0}; }
#pragma unroll
            for (int i = 0; i < KN_IT; ++i) {
                const int tok = gw + i * NGW;
                float f[8], ss = 0.f;
#pragma unroll
                for (int j = 0; j < 8; ++j) { f[j] = (float)kv[i][j]; ss += f[j] * f[j]; }
                ss += __shfl_xor(ss, 1); ss += __shfl_xor(ss, 2); ss += __shfl_xor(ss, 4); ss += __shfl_xor(ss, 8);
                const float rk = 1.0f / sqrtf(ss * (1.0f / 128.0f) + EPS);
                u32x4 w; w.x = pk_h2(f[0] * rk, f[1] * rk); w.y = pk_h2(f[2] * rk, f[3] * rk); w.z = pk_h2(f[4] * rk, f[5] * rk); w.w = pk_h2(f[6] * rk, f[7] * rk);
                if (tok < NT) *(u32x4*)(KNw + (size_t)tok * 512 + 8 * lane_k) = w;
            }
            for (int tok = gw + KN_IT * NGW; tok < NT; tok += NGW) {
                const h8 k8 = *(const h8*)(KBm + (size_t)tok * 512 + 8 * lane_k);
                float f[8], ss = 0.f;
#pragma unroll
                for (int j = 0; j < 8; ++j) { f[j] = (float)k8[j]; ss += f[j] * f[j]; }
                ss += __shfl_xor(ss, 1); ss += __shfl_xor(ss, 2); ss += __shfl_xor(ss, 4); ss += __shfl_xor(ss, 8);
                const float rk = 1.0f / sqrtf(ss * (1.0f / 128.0f) + EPS);
                u32x4 w; w.x = pk_h2(f[0] * rk, f[1] * rk); w.y = pk_h2(f[2] * rk, f[3] * rk); w.z = pk_h2(f[4] * rk, f[5] * rk); w.w = pk_h2(f[6] * rk, f[7] * rk);
                *(u32x4*)(KNw + (size_t)tok * 512 + 8 * lane_k) = w;
            }
        }
        {
            LAS unsigned char* ring = lds;
            LAS float* scw = (LAS float*)(lds + 65536) + wave * SEQ;
            const int r32 = lane & 31, hi = lane >> 5;
            unsigned voffI[2];
#pragma unroll
            for (int i = 0; i < 2; ++i) { const int Gn = (wave * 2 + i) * 64 + lane, row = Gn >> 4, cg = (Gn & 15) ^ (row & 15); voffI[i] = (unsigned)(row * 128 + cg * 8); }
            for (int un = blk; un < 512; un += G) {
                const int jj = un & 255, b = 2 * (jj >> 7) + (un >> 8), qb = (un >> 8) ? 127 - (jj & 127) : (jj & 127);
                const int q0 = 16 * qb, tA = q0 + 2 * wave, tB = tA + 1;
                const int ngr = (q0 + 15) / 64 + 1;
                const size_t tokA = (size_t)b * SEQ + tA;
                const _Float16* kib = KIm + (size_t)b * SEQ * 128;
                h8 qaA[8], qaB[8]; float wA[16], wB[16];
                {
                    int r32_p = r32, hi_p = hi; asm volatile("" : "+v"(r32_p), "+v"(hi_p));
                    const _Float16* qp = QIm + tokA * 4096 + r32_p * 128 + 8 * hi_p;
#pragma unroll
                    for (int kk = 0; kk < 8; ++kk) { qaA[kk] = __builtin_nontemporal_load((const h8*)(qp + 16 * kk)); qaB[kk] = __builtin_nontemporal_load((const h8*)(qp + 4096 + 16 * kk)); }
                    const float* wp = WI + tokA * 32 + 4 * hi_p;
#pragma unroll
                    for (int r = 0; r < 16; ++r) { wA[r] = wp[(r & 3) + 8 * (r >> 2)]; wB[r] = wp[32 + (r & 3) + 8 * (r >> 2)]; }
                }
                float scB[32];
#pragma unroll
                for (int i = 0; i < 32; ++i) scB[i] = 0.f;
                __syncthreads();
#define IDX_DMA(c_) do { _Pragma("unroll") for (int i_ = 0; i_ < 2; ++i_) \
        __builtin_amdgcn_global_load_lds((const unsigned*)(kib + (size_t)(64 * (c_)) * 128 + voffI[i_]), (LAS unsigned*)(ring + ((c_) & 3) * 16384 + (wave * 2 + i_) * 1024), 16, 0, 0); } while (0)
                IDX_DMA(0); if (1 < ngr) IDX_DMA(1); if (2 < ngr) IDX_DMA(2);
                const bool grpY = wave >= 4;
                f32x16 aA0, aB0, aA1, aB1;
                int cpend = -1;
#define IDX_EPI(cc_) do { \
                    float sa = 0.f, sb = 0.f, sc1 = 0.f, sd = 0.f; \
                    _Pragma("unroll") for (int r = 0; r < 16; ++r) {     \
                        sa = __builtin_fmaf(wA[r], relu1(aA0[r]), sa); sb = __builtin_fmaf(wB[r], relu1(aB0[r]), sb); \
                        sc1 = __builtin_fmaf(wA[r], relu1(aA1[r]), sc1); sd = __builtin_fmaf(wB[r], relu1(aB1[r]), sd); } \
                      \
                    const float mineA = (lane < 32) ? sa : sc1, othA = (lane < 32) ? sc1 : sa; \
                    const float mineB = (lane < 32) ? sb : sd, othB = (lane < 32) ? sd : sb; \
                    const float totA = mineA + __shfl_xor(othA, 32), totB = mineB + __shfl_xor(othB, 32); \
                    scw[64 * (cc_) + lane] = totA; \
                    _Pragma("unroll") for (int i = 0; i < 32; ++i) scB[i] = (i == (cc_)) ? totB : scB[i]; \
                } while (0)
#pragma unroll 1
                for (int c = 0; c < ngr; ++c) {
                    const int rem = ngr - 1 - c;
                    if (rem >= 2) asm volatile("s_waitcnt vmcnt(4)" ::: "memory"); else if (rem == 1) asm volatile("s_waitcnt vmcnt(2)" ::: "memory"); else asm volatile("s_waitcnt vmcnt(0)" ::: "memory");
                    __builtin_amdgcn_s_barrier();
                    asm volatile("" ::: "memory");
                    if (c + 3 < ngr) IDX_DMA(c + 3);
                    if (grpY && cpend >= 0) { IDX_EPI(cpend); cpend = -1; }
                    if (64 * c <= tB) {
                        const LAS unsigned char* rb = ring + (c & 3) * 16384;
                        const LAS unsigned char* rp0 = rb + r32 * 256;
                        h8 f0[8], f1[8];
#pragma unroll
                        for (int kk = 0; kk < 8; ++kk) { f0[kk] = *(const LAS h8*)(rp0 + (((2 * kk + hi) ^ (r32 & 15)) << 4)); f1[kk] = *(const LAS h8*)(rp0 + 8192 + (((2 * kk + hi) ^ (r32 & 15)) << 4)); }
#pragma unroll
                        for (int r = 0; r < 16; ++r) { aA0[r] = 0.f; aB0[r] = 0.f; aA1[r] = 0.f; aB1[r] = 0.f; }
                        __builtin_amdgcn_s_setprio(1);
#pragma unroll
                        for (int kk = 0; kk < 8; ++kk) {
                            aA0 = __builtin_amdgcn_mfma_f32_32x32x16_f16(qaA[kk], f0[kk], aA0, 0, 0, 0);
                            aB0 = __builtin_amdgcn_mfma_f32_32x32x16_f16(qaB[kk], f0[kk], aB0, 0, 0, 0);
                        }
#pragma unroll
                        for (int kk = 0; kk < 8; ++kk) {
                            aA1 = __builtin_amdgcn_mfma_f32_32x32x16_f16(qaA[kk], f1[kk], aA1, 0, 0, 0);
                            aB1 = __builtin_amdgcn_mfma_f32_32x32x16_f16(qaB[kk], f1[kk], aB1, 0, 0, 0);
                        }
                        __builtin_amdgcn_s_setprio(0);
                        if (grpY) cpend = c; else IDX_EPI(c);
                    }
                }
                if (grpY && cpend >= 0) IDX_EPI(cpend);
#undef IDX_EPI
#undef IDX_DMA
                {
                    unsigned uk[32];
                    int lane_o = lane; asm volatile("" : "+v"(lane_o));
                    const LAS float* sl = scw + lane_o;
#pragma unroll
                    for (int i = 0; i < 32; ++i) { const unsigned bits = __float_as_uint(sl[64 * i]); uk[i] = (64 * i + lane_o <= tA) ? ((bits & 0x80000000u) ? ~bits : (bits | 0x80000000u)) : 0u; }
                    asm volatile("s_waitcnt lgkmcnt(0)" ::: "memory");
                    topk_select(uk, tA, MASK + tokA * 64, lane_o, (LAS unsigned*)scw);
#pragma unroll
                    for (int i = 0; i < 32; ++i) { const unsigned bits = __float_as_uint(scB[i]); uk[i] = (64 * i + lane_o <= tB) ? ((bits & 0x80000000u) ? ~bits : (bits | 0x80000000u)) : 0u; }
                    topk_select(uk, tB, MASK + (tokA + 1) * 64, lane_o, (LAS unsigned*)scw);
                }
            }
        }
        __syncthreads();
        {
            const GmlpPar gp{a.ln_v_g, a.ln_v_b, a.b_s, a.out_norm_a_g};
            for (int un = gmlp_pre + blk; un < NB * 16 * 16; un += G) gmlp_unit(un, UBl, VBl, GABl, (const _Float16*)(ws + WS_WS16), VSTAT, Y, SSQA, gp, lds, tid, lane, wave);
        }
    }
    SEAM(3);

    if (IN(4)) {
        using namespace att;
        const int r32 = lane & 31, hi = lane >> 5, hr = wave & 3, qh = wave >> 2;
        LAS unsigned char* V_lds = lds + L_V; LAS unsigned char* K_lds = lds + L_K;
        LAS unsigned* mask_l = (LAS unsigned*)(lds + L_MSK); LAS float* li_l = (LAS float*)(lds + L_LI) + wave * 32;
        LAS float* dtab = (LAS float*)(lds + L_DT); LAS int* bucket = (LAS int*)(lds + L_BK);
        const _Float16* KN = (const _Float16*)(ws + WS_KN);
        const int vb0 = (int)(uintptr_t)V_lds + v_rd_base(lane);
        unsigned voffV[2], voffK[2];
#pragma unroll
        for (int i = 0; i < 2; ++i) {
            const int Gn = (wave * 2 + i) * 64 + lane;
            const int kk = ((Gn >> 7) << 3) | ((Gn >> 2) & 7), c = ((Gn >> 5) & 3) * 32 + (Gn & 3) * 8;
            const int k = (kk & ~0xC) | ((kk & 4) << 1) | ((kk & 8) >> 1);
            voffV[i] = (unsigned)(k * 512 + c);
            const int row = Gn >> 4, cg = (Gn & 15) ^ (row & 7);
            voffK[i] = (unsigned)(row * 512 + cg * 8);
        }
        LAS float* gqk_l = (LAS float*)(lds + L_GQK); LAS float* rb_l = (LAS float*)(lds + L_RB);
        if (tid < 128) {
            const int n = tid; int bk;
            if (n < 16) bk = n; else { bk = 16 + (int)(logf((float)n / 16.0f) / 2.0794415416798357f * 16.0f); bk = bk < 31 ? bk : 31; }
            bucket[n] = bk;
            gqk_l[n] = a.q_norm_g[n] * a.k_norm_g[n] * (1.44269504089f * 0.08838834764831845f);
        }
        rb_l[tid] = a.rel_bias[tid];
        for (int cu0 = blk; cu0 < 256; cu0 += G) {
            const int cu = (G == 256) ? (((cu0 & 7) * 2 + (cu0 >> 7)) * 16 + ((cu0 >> 3) & 15)) : cu0;
            const int bg = cu >> 4, b = bg >> 2, g = bg & 3, ci = cu & 15;
            const int h = 4 * g + hr;
            __syncthreads();
            int tid_o = tid; asm volatile("" : "+v"(tid_o));
            for (int i = tid_o; i < 1024; i += 512) {
                const int hh = i >> 8, dist = (i & 255) - 64;
                float v = 0.f;
                if (dist >= 0 && dist < 113) v = (rb_l[bucket[dist] * 16 + 4 * g + hh] - rb_l[31 * 16 + 4 * g + hh]) * 1.44269504089f;
                dtab[i] = v;
            }
            const _Float16* Kh = KN + (size_t)b * SEQ * 512 + g * 128; const _Float16* Vh = VVm + (size_t)b * SEQ * 512 + g * 128;
#pragma unroll 1
            for (int uu = 0; uu < 2; ++uu) {
                const int qb = uu == 0 ? (31 - ci) : ci;
                const int NTL = qb + 1;
                const int ql = 32 * qh + r32, t = 64 * qb + ql;
#define ATT_DMA(bf, k0) do { _Pragma("unroll") for (int i_ = 0; i_ < 2; ++i_) { \
        __builtin_amdgcn_global_load_lds((const unsigned*)(Vh + (size_t)(k0) * 512 + voffV[i_]), (LAS unsigned*)(V_lds + (bf) * 16384 + (wave * 2 + i_) * 1024), 16, 0, 0); \
        __builtin_amdgcn_global_load_lds((const unsigned*)(Kh + (size_t)(k0) * 512 + voffK[i_]), (LAS unsigned*)(K_lds + (bf) * 16384 + (wave * 2 + i_) * 1024), 16, 0, 0); } } while (0)
                __syncthreads();
                ATT_DMA(0, 0);
                {
                    const unsigned* mg = MASK + ((size_t)b * SEQ + 64 * qb) * 64;
                    int tid_m = tid; asm volatile("" : "+v"(tid_m));
#pragma unroll
                    for (int p = 0; p < 2; ++p) { const int e = p * 512 + tid_m; const u32x4 w = *(const u32x4*)(mg + e * 4); const int q = e >> 4, wq = (e & 15) * 4;
                        LAS unsigned* d = mask_l + q * 66 + wq; *(LAS u32x2*)d = (u32x2){w.x, w.y}; *(LAS u32x2*)(d + 2) = (u32x2){w.z, w.w}; }
                }
                h8 qr[8];
                {
                    int hi_p = hi, t_p = t; asm volatile("" : "+v"(hi_p), "+v"(t_p));
                    const _Float16* qp = QBm + ((size_t)b * SEQ + t_p) * 2048 + h * 128 + 8 * hi_p;
                    float ss = 0.f;
#pragma unroll
                    for (int d0 = 0; d0 < 8; ++d0) { qr[d0] = __builtin_nontemporal_load((const h8*)(qp + 16 * d0));
#pragma unroll
                        for (int j = 0; j < 8; ++j) { const float f = (float)qr[d0][j]; ss += f * f; } }
                    ss += __shfl_xor(ss, 32);
                    const float rs = 1.0f / sqrtf(ss * (1.0f / 128.0f) + EPS);
#pragma unroll
                    for (int d0 = 0; d0 < 8; ++d0) {
                        const f32x4 g0 = *(const LAS f32x4*)(gqk_l + 16 * d0 + 8 * hi_p), g1 = *(const LAS f32x4*)(gqk_l + 16 * d0 + 8 * hi_p + 4);
                        h8 o8;
#pragma unroll
                        for (int j = 0; j < 4; ++j) { o8[j] = (_Float16)((float)qr[d0][j] * rs * g0[j]); o8[4 + j] = (_Float16)((float)qr[d0][4 + j] * rs * g1[j]); }
                        qr[d0] = o8;
                    }
                }
                f32x16 o[4];
#pragma unroll
                for (int d = 0; d < 4; ++d)
#pragma unroll
                    for (int r = 0; r < 16; ++r) o[d][r] = 0.f;
                float lsum = 0.f;
                const LAS unsigned* mq = mask_l + ql * 66;
                __syncthreads();
#define ATT_PK4(P, BASE, OUT) do { unsigned a0 = cvtpk_bf16(P[BASE + 0], P[BASE + 1]), a1 = cvtpk_bf16(P[BASE + 2], P[BASE + 3]); \
        unsigned b0 = cvtpk_bf16(P[BASE + 4], P[BASE + 5]), b1 = cvtpk_bf16(P[BASE + 6], P[BASE + 7]); \
        auto r0 = __builtin_amdgcn_permlane32_swap(a0, b0, false, false); auto r1 = __builtin_amdgcn_permlane32_swap(a1, b1, false, false); \
        u32x4 w = {r0[0], r1[0], r0[1], r1[1]}; OUT = __builtin_bit_cast(bf16x8, w); } while (0)
#define ATT_TILE(BF, J) do { \
                    const int j_ = (J); \
                    if (j_ + 1 < NTL) ATT_DMA((BF) ^ 1, 64 * (j_ + 1)); \
                    f32x16 p0, p1; \
                    qkt(p0, p1, K_lds + (BF) * 16384, qr, r32, hi); \
                    { \
                        const u32x2 mw = *(const LAS u32x2*)(mq + 2 * j_); \
                        const unsigned w0 = mw.x >> (4 * hi), w1 = mw.y >> (4 * hi); \
                        if (j_ >= NTL - 3) { \
                            const LAS float* dt = dtab + hr * 256 + (t - 64 * j_ + 64 - 4 * hi - 63); \
                            _Pragma("unroll") for (int r = 0; r < 16; ++r) { const int c = (r & 3) + 8 * (r >> 2); p0[r] += dt[63 - c]; p1[r] += dt[63 - c - 32]; } \
                        } \
                        _Pragma("unroll") for (int r = 0; r < 16; ++r) { \
                            const int c = (r & 3) + 8 * (r >> 2); \
                            const float e0 = __builtin_amdgcn_exp2f(p0[r]), e1 = __builtin_amdgcn_exp2f(p1[r]); \
                            p0[r] = ((w0 >> c) & 1u) ? e0 : 0.f; p1[r] = ((w1 >> c) & 1u) ? e1 : 0.f; \
                            lsum += p0[r] + p1[r]; \
                        } \
                    } \
                    bf16x8 pa0, pa1, pa2, pa3; \
                    ATT_PK4(p0, 0, pa0); ATT_PK4(p0, 8, pa1); ATT_PK4(p1, 0, pa2); ATT_PK4(p1, 8, pa3); \
                    ATT_SBAR(); \
                    const int vb = vb0 + (BF) * 16384; \
                    pv_one<0>(o[0], vb, pa0, pa1, pa2, pa3); pv_one<1>(o[1], vb, pa0, pa1, pa2, pa3); pv_one<2>(o[2], vb, pa0, pa1, pa2, pa3); pv_one<3>(o[3], vb, pa0, pa1, pa2, pa3); \
                    __syncthreads(); \
                } while (0)
                {
                    int j = 0;
#pragma unroll 1
                    for (; j + 1 < NTL; j += 2) { ATT_TILE(0, j); ATT_TILE(1, j + 1); }
                    if (j < NTL) ATT_TILE(0, j);
                }
#undef ATT_TILE
                int t_e = 64 * qb + 32 * qh, r32_e = r32, hi_e = hi; asm volatile("" : "+v"(t_e), "+v"(r32_e), "+v"(hi_e));
                lsum += __shfl_xor(lsum, 32);
                if (hi_e == 0) li_l[r32_e] = lsum;
                asm volatile("s_waitcnt lgkmcnt(0)" ::: "memory");
                LAS _Float16* ot = (LAS _Float16*)(lds + L_V) + wave * 4096;
#pragma unroll
                for (int r = 0; r < 16; ++r) {
                    const int qrow = crow(r, hi_e);
                    const float rl = __builtin_amdgcn_rcpf(li_l[qrow]);
                    float ssq = 0.f;
#pragma unroll
                    for (int d0 = 0; d0 < 4; ++d0) { const float ov = o[d0][r] * rl; ssq += ov * ov; ot[qrow * 128 + 32 * d0 + r32_e] = (_Float16)ov; }
#pragma unroll
                    for (int of = 1; of < 32; of <<= 1) ssq += __shfl_xor(ssq, of);
                    if (r32_e == 0) SSQB[((size_t)b * SEQ + t_e + qrow) * 16 + h] = ssq;
                }
                asm volatile("s_waitcnt lgkmcnt(0)" ::: "memory");
                {
                    int lane_e = lane; asm volatile("" : "+v"(lane_e));
                    const int c16 = lane_e & 15, qs = lane_e >> 4;
                    const f32x4 og0 = *(const f32x4*)(a.out_norm_b_g + h * 128 + 8 * c16), og1 = *(const f32x4*)(a.out_norm_b_g + h * 128 + 8 * c16 + 4);
#pragma unroll
                    for (int hf = 0; hf < 2; ++hf) {
                    h8 gbv[4], ovv[4];
#pragma unroll
                    for (int i = 0; i < 4; ++i) {
                        const int q = qs + 4 * (4 * hf + i); const size_t tk = (size_t)b * SEQ + t_e + q;
                        gbv[i] = __builtin_nontemporal_load((const h8*)(GBm + tk * 2048 + h * 128 + 8 * c16));
                        ovv[i] = *(const LAS h8*)(ot + q * 128 + 8 * c16);
                    }
#pragma unroll
                    for (int i = 0; i < 4; ++i) {
                        const int q = qs + 4 * (4 * hf + i); const size_t tk = (size_t)b * SEQ + t_e + q;
                        u32x4 w;
                        w.x = pk_h2((float)ovv[i][0] * og0[0] * (float)gbv[i][0], (float)ovv[i][1] * og0[1] * (float)gbv[i][1]);
                        w.y = pk_h2((float)ovv[i][2] * og0[2] * (float)gbv[i][2], (float)ovv[i][3] * og0[3] * (float)gbv[i][3]);
                        w.z = pk_h2((float)ovv[i][4] * og1[0] * (float)gbv[i][4], (float)ovv[i][5] * og1[1] * (float)gbv[i][5]);
                        w.w = pk_h2((float)ovv[i][6] * og1[2] * (float)gbv[i][6], (float)ovv[i][7] * og1[3] * (float)gbv[i][7]);
                        *(u32x4*)(Y + tk * DM + 2048 + h * 128 + 8 * c16) = w;
                    }
                    asm volatile("" ::: "memory");
                    }
                }
#undef ATT_DMA
#undef ATT_PK4
            }
        }
    }
    SEAM(4);

    if (IN(5)) {
        pg8::Gemm g{Y, WTout, NT, DM, DM}; pg8::StaticOrder S; S.init(NT, DM, G, blk);
        EpiOut E{a.x, a.out, MOD, SSQA, SSQB};
        pg8::gemm_phase<EpiOut>(lds, g, S, E);
    }
#undef IN
#undef SEAM
}

extern "C" void kernel_launch(void* const* d_in, const int* in_sizes, int n_in, void* d_out, int out_size, void* d_ws, size_t ws_size, hipStream_t stream) {
    static int grid = 0;
    if (grid == 0) {
        if (n_in != 16 || out_size != NT * DM || ws_size < WS_END) { fprintf(stderr, "kernel_launch: unexpected shapes (n_in %d out %d ws %zu)\n", n_in, out_size, ws_size); grid = -1; return; }
        int dev = 0, cus = 0, per_cu = 0;
        hipGetDevice(&dev);
        hipDeviceGetAttribute(&cus, hipDeviceAttributeMultiprocessorCount, dev);
        hipFuncSetAttribute((const void*)fwd_kernel, hipFuncAttributeMaxDynamicSharedMemorySize, LDS_BYTES);
        hipOccupancyMaxActiveBlocksPerMultiprocessor(&per_cu, (const void*)fwd_kernel, 512, LDS_BYTES);
        if (per_cu < 1) { fprintf(stderr, "kernel_launch: occupancy query says %d blocks per CU\n", per_cu); grid = -1; return; }
        grid = cus;
        if (grid > 256) grid = 256;
        (void)hipGetLastError();
    }
    if (grid < 0) return;
    Args a{};
    a.x = (const float*)d_in[0]; a.c = (const float*)d_in[1]; a.w_ada = (const float*)d_in[2]; a.b_ada = (const float*)d_in[3]; a.norm_g = (const float*)d_in[4];
    a.w_in = (const float*)d_in[5]; a.ln_v_g = (const float*)d_in[6]; a.ln_v_b = (const float*)d_in[7]; a.w_s = (const float*)d_in[8]; a.b_s = (const float*)d_in[9];
    a.q_norm_g = (const float*)d_in[10]; a.k_norm_g = (const float*)d_in[11]; a.rel_bias = (const float*)d_in[12]; a.out_norm_a_g = (const float*)d_in[13];
    a.out_norm_b_g = (const float*)d_in[14]; a.w_out = (const float*)d_in[15];
    a.out = (float*)d_out; a.ws = (unsigned char*)d_ws; a.ph_lo = 0; a.ph_hi = 6;
    (void)hipMemsetAsync(d_ws, 0, XCD_BAR_WORDS * 4 + 256, stream);
    void* args[] = {&a};
    hipError_t e = hipLaunchCooperativeKernel((const void*)fwd_kernel, dim3(grid), dim3(512), args, LDS_BYTES, stream);
    if (e != hipSuccess) fprintf(stderr, "kernel_launch: cooperative launch failed: %s (grid %d)\n", hipGetErrorString(e), grid);
}
```

```cpp
#include <hip/hip_runtime.h>
#include <hip/hip_cooperative_groups.h>
#include <cstdio>
#include <cstdint>
namespace cg = cooperative_groups;

#define LAS __attribute__((address_space(3)))
typedef _Float16 h8 __attribute__((ext_vector_type(8)));
typedef _Float16 h4 __attribute__((ext_vector_type(4)));
typedef _Float16 h2 __attribute__((ext_vector_type(2)));
typedef float f32x2 __attribute__((ext_vector_type(2)));
typedef float f32x4 __attribute__((ext_vector_type(4)));
typedef float f32x16 __attribute__((ext_vector_type(16)));
typedef unsigned u32x2 __attribute__((ext_vector_type(2)));
typedef unsigned u32x4 __attribute__((ext_vector_type(4)));

constexpr int NB = 4, SEQ = 2048, DM = 4096, NT = NB * SEQ;
constexpr int NZ = 15520, NZP = 15616;
constexpr int C_U = 0, C_V = 2048, C_GA = 4096, C_QB = 6144, C_KB = 8192, C_VB = 8704, C_GB = 9216, C_QI = 11264, C_KI = 15360, C_WI = 15488;
constexpr float EPS = 1e-6f;
constexpr int TOPK = 256;
constexpr int KSPLIT = 16;

constexpr size_t MiB = 1u << 20;
constexpr size_t WS_WTIN = 1 * MiB;
constexpr size_t WS_WTOUT = 123 * MiB;
constexpr size_t WS_H = 155 * MiB;
constexpr size_t WS_U = 219 * MiB;
constexpr size_t WS_V = 251 * MiB;
constexpr size_t WS_GA = 283 * MiB;
constexpr size_t WS_QB = 315 * MiB;
constexpr size_t WS_KB = 347 * MiB;
constexpr size_t WS_VV = 355 * MiB;
constexpr size_t WS_GB = 363 * MiB;
constexpr size_t WS_QI = 395 * MiB;
constexpr size_t WS_KI = 459 * MiB;
constexpr size_t WS_WI = 463 * MiB;
constexpr size_t WS_MODP = 464 * MiB;
constexpr size_t WS_MOD = 467 * MiB;
constexpr size_t WS_VSTAT = 468 * MiB;
constexpr size_t WS_MASK = 470 * MiB;
constexpr size_t WS_Y = 472 * MiB;
constexpr size_t WS_SSQA = 536 * MiB;
constexpr size_t WS_SSQB = 537 * MiB;
constexpr size_t WS_KN = 538 * MiB;
constexpr size_t WS_WS16 = 546 * MiB;
constexpr size_t WS_END = 547 * MiB;

constexpr int LDS_BYTES = 147456;
constexpr int LDS_X = 131072;

__device__ __forceinline__ float wave_sum(float v) {
#pragma unroll
    for (int o = 1; o < 64; o <<= 1) v += __shfl_xor(v, o);
    return v;
}
__device__ __forceinline__ float wave_max(float v) {
#pragma unroll
    for (int o = 1; o < 64; o <<= 1) v = fmaxf(v, __shfl_xor(v, o));
    return v;
}
constexpr float Y8_SA = 8.f, Y8_SB = 32.f, W8_S = 256.f;
__device__ __forceinline__ float clamp448(float v) { return __builtin_amdgcn_fmed3f(v, -448.f, 448.f); }
__device__ __forceinline__ unsigned pk_fp8x4(float a, float b, float c, float d) {
    int r = __builtin_amdgcn_cvt_pk_fp8_f32(clamp448(a), clamp448(b), 0, false); r = __builtin_amdgcn_cvt_pk_fp8_f32(clamp448(c), clamp448(d), r, true); return (unsigned)r; }
__device__ __forceinline__ unsigned pk_h2(float lo, float hi) { h2 v = {(_Float16)lo, (_Float16)hi}; return __builtin_bit_cast(unsigned, v); }
__device__ __forceinline__ float fast_exp(float x) { return __builtin_amdgcn_exp2f(x * 1.44269504089f); }
__device__ __forceinline__ float gelu_tanh(float x) {
    const float u = 1.5957691216f * (x + 0.044715f * x * x * x);
    return x * __builtin_amdgcn_rcpf(1.0f + fast_exp(-u));
}
__device__ __forceinline__ float relu1(float x) { float r; asm("v_max_f32 %0, 0, %1" : "=v"(r) : "v"(x)); return r; }
__device__ __forceinline__ float silu_f(float x) { return x * __builtin_amdgcn_rcpf(1.0f + fast_exp(-x)); }
__device__ __forceinline__ unsigned cvtpk_bf16(float lo, float hi) { unsigned r; asm volatile("v_cvt_pk_bf16_f32 %0, %1, %2" : "=v"(r) : "v"(lo), "v"(hi)); return r; }

namespace pg8 {
constexpr int BM = 256, BK = 64, HALF = 128, HTB = HALF * BK * 2, STAGE_BYTES = 8 * HTB, NXCD = 8, WGM = 8;
__host__ __device__ __forceinline__ int lds_byte(int r, int c) { const int st = (r >> 4) * 2 + (c >> 5), rr = r & 15, cc = c & 31, ob = rr * 64 + cc * 2; return st * 1024 + (ob ^ (((ob >> 9) & 1) << 5)); }
__host__ __device__ __forceinline__ void stage_rc(int b, int& R, int& C) { const int st = b / 1024, sb = b % 1024, swz = sb ^ (((sb >> 9) & 1) << 5); R = (st >> 1) * 16 + swz / 64; C = (st & 1) * 32 + (swz % 64) / 2; }
__host__ __device__ __forceinline__ int perm32(int rho) { const int n = rho >> 4, i = rho & 15; return 8 * (i >> 2) + 4 * n + (i & 3); }
typedef int i32x8 __attribute__((ext_vector_type(8)));
__device__ __forceinline__ i32x8 pg8_cat(h8 lo, h8 hi) { const u32x4 a = __builtin_bit_cast(u32x4, lo), b = __builtin_bit_cast(u32x4, hi); return (i32x8){(int)a.x, (int)a.y, (int)a.z, (int)a.w, (int)b.x, (int)b.y, (int)b.z, (int)b.w}; }
struct Unit { int pm, pn; };
struct Gemm { const void* A; const void* Bt; int M, N, K; };
struct StaticOrder {
    int nM, nN, nwg, G, c;
    __host__ __device__ void init(int M, int N, int G_, int c_) { nM = M / BM; nN = N / BM; nwg = nM * nN; G = G_; c = c_; }
    __host__ __device__ bool next(int i, Unit& u) const {
        const long L = (long)i * G + c; if (L >= nwg) return false;
        int wgid = (int)L; { const int q = nwg / NXCD, r = nwg % NXCD, xcd = wgid % NXCD, off = wgid / NXCD; wgid = (xcd < r ? xcd * (q + 1) : r * (q + 1) + (xcd - r) * q) + off; }
        const int nig = WGM * nN, gid = wgid / nig, fm = gid * WGM, gsz = (nM - fm) < WGM ? (nM - fm) : WGM;
        u.pm = fm + ((wgid % nig) % gsz); u.pn = (wgid % nig) / gsz; return true;
    }
};

template <class Epi, bool ALIGN_EPI = true, bool SP2 = true, bool FP8 = false>
__device__ __forceinline__ void gemm_phase(LAS unsigned char* lds, const Gemm g, const StaticOrder& S, const Epi& E) {
    const int tid = threadIdx.x, wid = __builtin_amdgcn_readfirstlane(tid >> 6), lane = tid & 63, wr = wid >> 2, wc = wid & 3, fr = lane & 15, fq = lane >> 4;
    const int K = g.K, RB = FP8 ? K : 2 * K  , nt = RB / 128;
    unsigned voffA[2], voffB[2];
#pragma unroll
    for (int i = 0; i < 2; ++i) { int R, C; stage_rc(tid * 16 + i * 8192, R, C); const int Rb = Epi::PERM ? ((R & ~31) + perm32(R & 31)) : R;
        voffA[i] = (unsigned)(R * RB + 2 * C); voffB[i] = (unsigned)(Rb * RB + 2 * C); }
    const size_t kstep = (size_t)(BK * 2);
    const size_t hstep = (size_t)HALF * RB;
    const size_t tstep = 2 * hstep;
    const unsigned ldsw = (unsigned)wid * 1024u;
    const int aoff = lds_byte(wr * 64 + fr, fq * 8), boff = lds_byte(wc * 32 + fr, fq * 8);
#define PG8_SA(b, h) (((b) * 2 + (h)) * HTB)
#define PG8_SB(b, h) ((4 + (b) * 2 + (h)) * HTB)
#define PG8_STAGE(bufoff, gbase, voff) do { _Pragma("unroll") for (int _i = 0; _i < 2; ++_i) { unsigned _v = (voff)[_i]; if constexpr (FP8) asm volatile("" : "+v"(_v)); \
        __builtin_amdgcn_global_load_lds((const unsigned*)((const char*)(gbase) + _v), (LAS unsigned*)(lds + (bufoff) + ldsw + _i * 8192), 16, 0, 0); } } while (0)
#define PG8_LDA(dst, b, h) do { _Pragma("unroll") for (int m = 0; m < 4; ++m) _Pragma("unroll") for (int k = 0; k < 2; ++k) dst[m][k] = *(const LAS h8*)(lds + PG8_SA(b, h) + aoff + m * 2048 + k * 1024); } while (0)
#define PG8_LDB(dst, b, h) do { _Pragma("unroll") for (int n = 0; n < 2; ++n) _Pragma("unroll") for (int k = 0; k < 2; ++k) dst[n][k] = *(const LAS h8*)(lds + PG8_SB(b, h) + boff + n * 2048 + k * 1024); } while (0)
#define PG8_MMA(ai, bj, At, Bt) do { __builtin_amdgcn_s_setprio(1); \
        if constexpr (FP8) { _Pragma("unroll") for (int m = 0; m < 4; ++m) _Pragma("unroll") for (int n = 0; n < 2; ++n) \
            acc[ai][bj][m][n] = __builtin_amdgcn_mfma_scale_f32_16x16x128_f8f6f4(pg8_cat(Bt[n][0], Bt[n][1]), pg8_cat(At[m][0], At[m][1]), acc[ai][bj][m][n], 0, 0, 0, 0x7F7F7F7F, 0, 0x7F7F7F7F); } \
        else { _Pragma("unroll") for (int m = 0; m < 4; ++m) _Pragma("unroll") for (int n = 0; n < 2; ++n) _Pragma("unroll") for (int k = 0; k < 2; ++k) \
            acc[ai][bj][m][n] = __builtin_amdgcn_mfma_f32_16x16x32_f16(Bt[n][k], At[m][k], acc[ai][bj][m][n], 0, 0, 0); } \
        __builtin_amdgcn_s_setprio(0); } while (0)
#define PG8_WAIT_V(n) asm volatile("s_waitcnt vmcnt(" #n ")" ::: "memory")
#define PG8_WAIT_L(n) asm volatile("s_waitcnt lgkmcnt(" #n ")" ::: "memory")
#define PG8_BAR __builtin_amdgcn_s_barrier()
#define PG8_SCHED __builtin_amdgcn_sched_barrier(0)
    Unit cur, nxt; int ui = 0;
    if (!S.next(0, cur)) return;
    f32x4 acc[2][2][4][2];
#pragma unroll
    for (int a = 0; a < 2; ++a)
#pragma unroll
        for (int b = 0; b < 2; ++b)
#pragma unroll
            for (int m = 0; m < 4; ++m)
#pragma unroll
                for (int n = 0; n < 2; ++n) acc[a][b][m][n] = (f32x4){0.f, 0.f, 0.f, 0.f};
    h8 At[4][2], B0[2][2], B1[2][2];
    const char* cA = (const char*)g.A + (size_t)cur.pm * tstep; const char* cB = (const char*)g.Bt + (size_t)cur.pn * tstep;
    if constexpr (Epi::HAS_MID) E.begin(cur, ui, lds);
    if constexpr (SP2) {
        PG8_STAGE(PG8_SB(0, 0), cB, voffB); PG8_STAGE(PG8_SB(0, 1), cB + hstep, voffB); PG8_STAGE(PG8_SA(0, 0), cA, voffA); PG8_STAGE(PG8_SA(0, 1), cA + hstep, voffA);
        if (wr == 1) PG8_BAR;
        PG8_WAIT_V(2); PG8_BAR;
        PG8_STAGE(PG8_SB(1, 0), cB + kstep, voffB); PG8_STAGE(PG8_SA(1, 0), cA + kstep, voffA); PG8_STAGE(PG8_SB(1, 1), cB + hstep + kstep, voffB);
        PG8_WAIT_V(6); PG8_BAR;
    } else {
        PG8_STAGE(PG8_SB(0, 0), cB, voffB); PG8_STAGE(PG8_SA(0, 0), cA, voffA); PG8_STAGE(PG8_SB(0, 1), cB + hstep, voffB); PG8_STAGE(PG8_SA(0, 1), cA + hstep, voffA);
        if (wr == 1) PG8_BAR;
        PG8_WAIT_V(4); PG8_BAR;
        PG8_STAGE(PG8_SB(1, 0), cB + kstep, voffB); PG8_STAGE(PG8_SA(1, 0), cA + kstep, voffA); PG8_STAGE(PG8_SB(1, 1), cB + hstep + kstep, voffB);
        PG8_WAIT_V(6); PG8_BAR;
    }
    for (;;) {
        const bool has_next = S.next(ui + 1, nxt);
        const char* nA = has_next ? (const char*)g.A + (size_t)nxt.pm * tstep : cA; const char* nB = has_next ? (const char*)g.Bt + (size_t)nxt.pn * tstep : cB;
        for (int t = 0; t < nt; t += 2) {
            const bool last = (t == nt - 2);
            const char* a1 = cA + (size_t)(t + 1) * kstep;
            const char* a2 = last ? nA : cA + (size_t)(t + 2) * kstep; const char* b2 = last ? nB : cB + (size_t)(t + 2) * kstep;
            const char* a3 = a2 + kstep; const char* b3 = b2 + kstep;
            if constexpr (Epi::HAS_MID) { if (t == nt / 2) E.mid(acc, ui, wr, fr, lds); }
            if constexpr (SP2) {
            PG8_LDB(B0, 0, 0); PG8_LDB(B1, 0, 1); PG8_SCHED; PG8_LDA(At, 0, 0); PG8_STAGE(PG8_SA(1, 1), a1 + hstep, voffA);
            PG8_WAIT_V(8); PG8_WAIT_L(0); PG8_BAR; PG8_MMA(0, 0, At, B0); PG8_MMA(0, 1, At, B1); PG8_BAR; PG8_SCHED;
            PG8_LDA(At, 0, 1); PG8_STAGE(PG8_SB(0, 0), b2, voffB); PG8_STAGE(PG8_SB(0, 1), b2 + hstep, voffB); PG8_STAGE(PG8_SA(0, 0), a2, voffA);
            PG8_WAIT_V(8); PG8_WAIT_L(0); PG8_BAR; PG8_MMA(1, 0, At, B0); PG8_MMA(1, 1, At, B1); PG8_BAR; PG8_SCHED;
            PG8_LDB(B0, 1, 0); PG8_LDB(B1, 1, 1); PG8_SCHED; PG8_LDA(At, 1, 0); PG8_STAGE(PG8_SA(0, 1), a2 + hstep, voffA);
            PG8_WAIT_V(8); PG8_WAIT_L(0); PG8_BAR; PG8_MMA(0, 0, At, B0); PG8_MMA(0, 1, At, B1); PG8_BAR; PG8_SCHED;
            PG8_LDA(At, 1, 1); PG8_STAGE(PG8_SB(1, 0), b3, voffB); PG8_STAGE(PG8_SB(1, 1), b3 + hstep, voffB); PG8_STAGE(PG8_SA(1, 0), a3, voffA);
            PG8_WAIT_V(8); PG8_WAIT_L(0); PG8_BAR; PG8_MMA(1, 0, At, B0); PG8_MMA(1, 1, At, B1); PG8_BAR; PG8_SCHED;
            } else {
            PG8_LDB(B0, 0, 0); PG8_SCHED; PG8_LDA(At, 0, 0); PG8_STAGE(PG8_SA(1, 1), a1 + hstep, voffA);
            PG8_WAIT_L(8); PG8_BAR; PG8_WAIT_L(0); PG8_MMA(0, 0, At, B0); PG8_BAR; PG8_SCHED;
            PG8_LDB(B1, 0, 1); PG8_STAGE(PG8_SB(0, 0), b2, voffB);
            PG8_BAR; PG8_WAIT_L(0); PG8_MMA(0, 1, At, B1); PG8_BAR;
            PG8_LDA(At, 0, 1); PG8_STAGE(PG8_SA(0, 0), a2, voffA);
            PG8_BAR; PG8_WAIT_L(0); PG8_MMA(1, 0, At, B0); PG8_BAR; PG8_SCHED;
            PG8_STAGE(PG8_SB(0, 1), b2 + hstep, voffB);
            PG8_WAIT_V(6); PG8_BAR; PG8_MMA(1, 1, At, B1); PG8_BAR;
            PG8_LDB(B0, 1, 0); PG8_SCHED; PG8_LDA(At, 1, 0); PG8_STAGE(PG8_SA(0, 1), a2 + hstep, voffA);
            PG8_WAIT_L(8); PG8_BAR; PG8_WAIT_L(0); PG8_MMA(0, 0, At, B0); PG8_BAR; PG8_SCHED;
            PG8_LDB(B1, 1, 1); PG8_STAGE(PG8_SB(1, 0), b3, voffB);
            PG8_BAR; PG8_WAIT_L(0); PG8_MMA(0, 1, At, B1); PG8_BAR;
            PG8_LDA(At, 1, 1); PG8_STAGE(PG8_SA(1, 0), a3, voffA);
            PG8_BAR; PG8_WAIT_L(0); PG8_MMA(1, 0, At, B0); PG8_BAR; PG8_SCHED;
            PG8_STAGE(PG8_SB(1, 1), b3 + hstep, voffB);
            PG8_WAIT_V(6); PG8_BAR; PG8_MMA(1, 1, At, B1); PG8_BAR;
                    }
        }
        if constexpr (ALIGN_EPI) { if (wr == 0) PG8_BAR; }
        E(acc, cur, ui, wr, wc, fr, fq, lds);
        if constexpr (Epi::HAS_AFTER) E.after_unit(ui);
        if (!has_next) break;
#pragma unroll
        for (int a = 0; a < 2; ++a)
#pragma unroll
            for (int b = 0; b < 2; ++b)
#pragma unroll
                for (int m = 0; m < 4; ++m)
#pragma unroll
                    for (int n = 0; n < 2; ++n) acc[a][b][m][n] = (f32x4){0.f, 0.f, 0.f, 0.f};
        cur = nxt; cA = nA; cB = nB; ++ui;
        if constexpr (Epi::HAS_MID) E.begin(cur, ui, lds);
        if constexpr (ALIGN_EPI) { if (wr == 1) PG8_BAR; }
    }
    PG8_WAIT_V(0);
    if constexpr (!ALIGN_EPI) { if (wr == 0) PG8_BAR; }
    PG8_BAR;
#undef PG8_SA
#undef PG8_SB
#undef PG8_STAGE
#undef PG8_LDA
#undef PG8_LDB
#undef PG8_MMA
#undef PG8_WAIT_V
#undef PG8_WAIT_L
#undef PG8_BAR
#undef PG8_SCHED
}
}

struct EpiZ {
    static constexpr bool PERM = true, HAS_MID = false, HAS_AFTER = true;
    unsigned char* ws; float* WI; f32x2* VSTAT; unsigned* done5;
    __device__ __forceinline__ void begin(const pg8::Unit&, int, LAS unsigned char*) const {}
    __device__ __forceinline__ void mid(f32x4 (&)[2][2][4][2], int, int, int, LAS unsigned char*) const {}
    __device__ __forceinline__ void after_unit(int ui) const {
        if (ui == 5) {
            asm volatile("s_waitcnt vmcnt(0)" ::: "memory");
            __syncthreads();
            if (threadIdx.x == 0) {
                __builtin_amdgcn_fence(__ATOMIC_RELEASE, "agent");
                asm volatile("s_waitcnt vmcnt(0)" ::: "memory");
                __hip_atomic_fetch_add(done5, 1u, __ATOMIC_RELAXED, __HIP_MEMORY_SCOPE_AGENT);
            }
        }
    }
    __device__ __forceinline__ void operator()(const f32x4 (&acc)[2][2][4][2], const pg8::Unit& u, int, int wr, int wc, int fr, int fq, LAS unsigned char*) const {
        const int pn = u.pn;
        const int kind = pn < 16 ? 1 : ((pn < 24 || (pn >= 36 && pn < 44)) ? 2 : 0);
        const bool stats = (pn >= 8 && pn < 16);
        const bool blocked = pn < 24;
        size_t base; int ld, cofs;
        if (pn < 8) { base = WS_U; ld = 0; cofs = pn * 256; }
        else if (pn < 16) { base = WS_V; ld = 0; cofs = (pn - 8) * 256; }
        else if (pn < 24) { base = WS_GA; ld = 0; cofs = (pn - 16) * 256; }
        else if (pn < 32) { base = WS_QB; ld = 2048; cofs = (pn - 24) * 256; }
        else if (pn < 34) { base = WS_KB; ld = 512; cofs = (pn - 32) * 256; }
        else if (pn < 36) { base = WS_VV; ld = 512; cofs = (pn - 34) * 256; }
        else if (pn < 44) { base = WS_GB; ld = 2048; cofs = (pn - 36) * 256; }
        else if (pn < 60) { base = WS_QI; ld = 4096; cofs = (pn - 44) * 256; }
        else { base = WS_KI; ld = 128; cofs = 0; }
        _Float16* dst = (_Float16*)(ws + base);
        const int row0 = u.pm * 256 + wr * 64 + fr, cl = wc * 32 + 8 * fq;
#pragma unroll
        for (int ai = 0; ai < 2; ++ai)
#pragma unroll
            for (int m = 0; m < 4; ++m) {
                const int row = row0 + ai * 128 + m * 16;
                float s1 = 0.f, s2 = 0.f;
#pragma unroll
                for (int bj = 0; bj < 2; ++bj) {
                    float v[8];
#pragma unroll
                    for (int j = 0; j < 4; ++j) { v[j] = acc[ai][bj][m][0][j]; v[4 + j] = acc[ai][bj][m][1][j]; }
                    if (kind == 1) {
#pragma unroll
                        for (int j = 0; j < 8; ++j) v[j] = gelu_tanh(v[j]);
                    } else if (kind == 2) {
#pragma unroll
                        for (int j = 0; j < 8; ++j) v[j] = silu_f(v[j]);
                    }
                    if (stats) {
#pragma unroll
                        for (int j = 0; j < 8; ++j) { s1 += v[j]; s2 += v[j] * v[j]; }
                    }
                    u32x4 w;
                    if (pn == 34 || pn == 35) { w.x = cvtpk_bf16(v[0], v[1]); w.y = cvtpk_bf16(v[2], v[3]); w.z = cvtpk_bf16(v[4], v[5]); w.w = cvtpk_bf16(v[6], v[7]); }
                    else { w.x = pk_h2(v[0], v[1]); w.y = pk_h2(v[2], v[3]); w.z = pk_h2(v[4], v[5]); w.w = pk_h2(v[6], v[7]); }
                    if (blocked) {
                        const int head = (cofs >> 7) + bj;
                        *(u32x4*)(dst + ((size_t)((row >> 7) * 16 + head) * 128 + (row & 127)) * 128 + cl) = w;
                    } else if (pn < 60) {
                        *(u32x4*)(dst + (size_t)row * ld + cofs + bj * 128 + cl) = w;
                    } else if (bj == 0) {
                        *(u32x4*)(dst + (size_t)row * 128 + cl) = w;
                    } else if (wc == 0) {
                        float* wp = WI + (size_t)row * 32 + 8 * fq;
                        *(f32x4*)wp = (f32x4){v[0], v[1], v[2], v[3]} * 0.015625f;
                        *(f32x4*)(wp + 4) = (f32x4){v[4], v[5], v[6], v[7]} * 0.015625f;
                    }
                }
                if (stats) {
                    s1 += __shfl_xor(s1, 16); s1 += __shfl_xor(s1, 32);
                    s2 += __shfl_xor(s2, 16); s2 += __shfl_xor(s2, 32);
                    if (fq == 0) VSTAT[(size_t)row * 32 + (pn - 8) * 4 + wc] = (f32x2){s1, s2};
                }
            }
    }
};

struct EpiOut {
    static constexpr bool PERM = false, HAS_MID = true, HAS_AFTER = false;
    const float* x; float* out; const float* mod; const float* ssqa; const float* ssqb;
    __device__ __forceinline__ void begin(const pg8::Unit& u, int ui, LAS unsigned char* lds) const {
        const int tid = threadIdx.x;
        if (tid < 256) {
            const int row = u.pm * 256 + tid;
            const f32x4* pa = (const f32x4*)(ssqa + (size_t)row * 16);
            f32x4 a0 = pa[0], a1 = pa[1], a2 = pa[2], a3 = pa[3];
            const f32x4* pb = (const f32x4*)(ssqb + (size_t)row * 16);
            f32x4 b0 = pb[0], b1 = pb[1], b2 = pb[2], b3 = pb[3];
            b0 = (b0 + b1) + (b2 + b3);
            a0 = (a0 + a1) + (a2 + a3);
            const float sa = (a0[0] + a0[1]) + (a0[2] + a0[3]), sb = (b0[0] + b0[1]) + (b0[2] + b0[3]);
            const float ra = 1.0f / sqrtf(sa * (1.0f / 2048.0f) + EPS), rb = 1.0f / sqrtf(sb * (1.0f / 2048.0f) + EPS);
            LAS f32x2* F = (LAS f32x2*)(lds + LDS_X) + (ui & 1) * 256;
            F[tid] = (f32x2){(ra * Y8_SB) / (rb * Y8_SA), rb * (1.0f / (Y8_SB * W8_S))};
        }
    }
    __device__ __forceinline__ void mid(f32x4 (&acc)[2][2][4][2], int ui, int wr, int fr, LAS unsigned char* lds) const {
        asm volatile("" : "+v"(fr));
        const LAS f32x2* F = (const LAS f32x2*)(lds + LDS_X) + (ui & 1) * 256;
#pragma unroll
        for (int ai = 0; ai < 2; ++ai)
#pragma unroll
            for (int m = 0; m < 4; ++m) {
                const float r = F[ai * 128 + wr * 64 + m * 16 + fr].x;
#pragma unroll
                for (int bj = 0; bj < 2; ++bj)
#pragma unroll
                    for (int n = 0; n < 2; ++n) acc[ai][bj][m][n] = acc[ai][bj][m][n] * r;
            }
    }
    __device__ __forceinline__ void operator()(const f32x4 (&acc)[2][2][4][2], const pg8::Unit& u, int ui, int wr, int wc, int fr, int fq, LAS unsigned char* lds) const {
        asm volatile("" : "+v"(fr), "+v"(fq));
        const LAS f32x2* F = (const LAS f32x2*)(lds + LDS_X) + (ui & 1) * 256;
        const int b = u.pm >> 3;
        const int col0 = u.pn * 256 + wc * 32 + 4 * fq;
        f32x4 gv[2][2];
#pragma unroll
        for (int bj = 0; bj < 2; ++bj)
#pragma unroll
            for (int n = 0; n < 2; ++n) gv[bj][n] = *(const f32x4*)(mod + (size_t)b * 3 * DM + 2 * DM + col0 + bj * 128 + n * 16);
        f32x4 xa[2][2], xb[2][2];
#define EPO_LOAD(dst, g_) do { const int rl_ = ((g_) >> 2) * 128 + wr * 64 + ((g_) & 3) * 16 + fr; const size_t off_ = (size_t)(u.pm * 256 + rl_) * DM + col0; \
        _Pragma("unroll") for (int bj = 0; bj < 2; ++bj) _Pragma("unroll") for (int n = 0; n < 2; ++n) dst[bj][n] = *(const f32x4*)(x + off_ + bj * 128 + n * 16); } while (0)
#define EPO_STORE(src, g_) do { const int rl_ = ((g_) >> 2) * 128 + wr * 64 + ((g_) & 3) * 16 + fr; const size_t off_ = (size_t)(u.pm * 256 + rl_) * DM + col0; const float rb_ = F[rl_].y; \
        _Pragma("unroll") for (int bj = 0; bj < 2; ++bj) _Pragma("unroll") for (int n = 0; n < 2; ++n) \
            __builtin_nontemporal_store(src[bj][n] + gv[bj][n] * (acc[(g_) >> 2][bj][(g_) & 3][n] * rb_), (f32x4*)(out + off_ + bj * 128 + n * 16)); } while (0)
        EPO_LOAD(xa, 0);
        EPO_LOAD(xb, 1); EPO_STORE(xa, 0); asm volatile("" ::: "memory");
        EPO_LOAD(xa, 2); EPO_STORE(xb, 1); asm volatile("" ::: "memory");
        EPO_LOAD(xb, 3); EPO_STORE(xa, 2); asm volatile("" ::: "memory");
        EPO_LOAD(xa, 4); EPO_STORE(xb, 3); asm volatile("" ::: "memory");
        EPO_LOAD(xb, 5); EPO_STORE(xa, 4); asm volatile("" ::: "memory");
        EPO_LOAD(xa, 6); EPO_STORE(xb, 5); asm volatile("" ::: "memory");
        EPO_LOAD(xb, 7); EPO_STORE(xa, 6); asm volatile("" ::: "memory");
        EPO_STORE(xb, 7);
#undef EPO_LOAD
#undef EPO_STORE
    }
};


namespace att {
typedef short bf16x8 __attribute__((ext_vector_type(8)));
typedef short s16x4 __attribute__((ext_vector_type(4)));
#define ATT_KSWZ(row, colB) ((row) * 256 + ((colB) ^ (((row) & 7) << 4)))
#define ATT_SBAR() __builtin_amdgcn_sched_barrier(0)
__device__ __forceinline__ int crow(int r, int hi) { return (r & 3) + 8 * (r >> 2) + 4 * hi; }
__device__ __forceinline__ int v_st(int k, int c) { const int kk = (k & ~0xC) | ((k & 4) << 1) | ((k & 8) >> 1); return ((kk >> 3) * 4 + (c >> 5)) * 512 + ((kk & 7) * 32 + (c & 31)) * 2; }
__device__ __forceinline__ int v_rd_base(int lane) { return ((lane & 3) << 3) | (((lane >> 2) & 3) << 6) | (((lane >> 4) & 1) << 5) | (((lane >> 5) & 1) << 8); }
constexpr int v_rd_off(int d0, int ks, int half) { return d0 * 512 + ks * 4096 + half * 2048; }
template <int OFF> __device__ __forceinline__ s16x4 tr_read(int vb) {
    s16x4 r; asm volatile("ds_read_b64_tr_b16 %0, %1 offset:%2" : "=&v"(r) : "v"(vb), "i"(OFF) : "memory"); return r;
}
template <int D0> __device__ __forceinline__ void pv_one(f32x16& od, int vb, bf16x8 pa0, bf16x8 pa1, bf16x8 pa2, bf16x8 pa3) {
    const s16x4 l0 = tr_read<v_rd_off(D0, 0, 0)>(vb), h0 = tr_read<v_rd_off(D0, 0, 1)>(vb), l1 = tr_read<v_rd_off(D0, 1, 0)>(vb), h1 = tr_read<v_rd_off(D0, 1, 1)>(vb);
    const s16x4 l2 = tr_read<v_rd_off(D0, 2, 0)>(vb), h2 = tr_read<v_rd_off(D0, 2, 1)>(vb), l3 = tr_read<v_rd_off(D0, 3, 0)>(vb), h3 = tr_read<v_rd_off(D0, 3, 1)>(vb);
    asm volatile("s_waitcnt lgkmcnt(0)" ::: "memory"); ATT_SBAR();
#define ATT_PK(L, H) (bf16x8){L[0], L[1], L[2], L[3], H[0], H[1], H[2], H[3]}
    od = __builtin_amdgcn_mfma_f32_32x32x16_bf16(pa0, ATT_PK(l0, h0), od, 0, 0, 0);
    od = __builtin_amdgcn_mfma_f32_32x32x16_bf16(pa1, ATT_PK(l1, h1), od, 0, 0, 0);
    od = __builtin_amdgcn_mfma_f32_32x32x16_bf16(pa2, ATT_PK(l2, h2), od, 0, 0, 0);
    od = __builtin_amdgcn_mfma_f32_32x32x16_bf16(pa3, ATT_PK(l3, h3), od, 0, 0, 0);
#undef ATT_PK
}
__device__ __forceinline__ void qkt(f32x16& p0, f32x16& p1, const LAS unsigned char* Ks, const h8* qr, int r32, int hi) {
#pragma unroll
    for (int r = 0; r < 16; ++r) { p0[r] = 0.f; p1[r] = 0.f; }
#pragma unroll
    for (int d0 = 0; d0 < 8; ++d0) { const int cb = (d0 * 16 + hi * 8) * 2;
        const h8 b0 = *(const LAS h8*)(Ks + ATT_KSWZ(r32, cb));
        const h8 b1 = *(const LAS h8*)(Ks + ATT_KSWZ(32 + r32, cb));
        p0 = __builtin_amdgcn_mfma_f32_32x32x16_f16(b0, qr[d0], p0, 0, 0, 0);
        p1 = __builtin_amdgcn_mfma_f32_32x32x16_f16(b1, qr[d0], p1, 0, 0, 0); }
}
constexpr int L_V = 0, L_K = 32768, L_MSK = 65536, L_LI = L_MSK + 64 * 66 * 4, L_DT = L_LI + 1024, L_BK = L_DT + 4096, L_GQK = L_BK + 512, L_RB = L_GQK + 512, L_END = L_RB + 2048;
}


#define XB_TMO      128
#define XB_XCNT(j)  (256  + 64 * (j))
#define XB_XSUB(j)  (1280 + 64 * (j))
#define XB_XGEN(j)  (2304 + 64 * (j))
#define XB_TOP      3328
#define XB_TOPGEN   3392
#define XCD_BAR_WORDS 3456
#define XB_SPIN_CAP (1u << 18)
__device__ __forceinline__ unsigned xb_ld(unsigned* p)              { return __hip_atomic_load(p, __ATOMIC_RELAXED, __HIP_MEMORY_SCOPE_AGENT); }
__device__ __forceinline__ unsigned xb_add(unsigned* p, unsigned v) { return __hip_atomic_fetch_add(p, v, __ATOMIC_RELAXED, __HIP_MEMORY_SCOPE_AGENT); }
__device__ __forceinline__ unsigned xb_xcc_id() { return (unsigned)__builtin_amdgcn_s_getreg((3 << 11) | 20) & 0xFu; }
#define XB_SPIN(cond, bar) do { unsigned _sp = 0; while (cond) { __builtin_amdgcn_s_sleep(1); \
    if ((++_sp & 255u) == 0u) { if (xb_ld(&(bar)[XB_TMO])) break; if (_sp > XB_SPIN_CAP) { atomicAdd(&(bar)[XB_TMO], 1u); break; } } } } while (0)
struct XcdBarrier { unsigned* bar; unsigned x; volatile LAS unsigned* st; };
__device__ __forceinline__ XcdBarrier xcd_barrier_post(unsigned* bar, volatile LAS unsigned* st) {
    XcdBarrier b; b.bar = bar; b.x = xb_xcc_id(); b.st = st;
    if (threadIdx.x == 0) (void)xb_add(&bar[XB_XCNT(b.x)], 1u);
    return b;
}
__device__ __forceinline__ void xcd_barrier_complete(unsigned* bar, unsigned x, unsigned& nloc, unsigned& nx) {
    const unsigned G = gridDim.x * gridDim.y * gridDim.z;
    unsigned sum, cnt, mine, sp = 0u;
    for (;;) {
        sum = 0u; cnt = 0u; mine = 0u;
#pragma unroll
        for (unsigned j = 0; j < 16; ++j) { const unsigned c = xb_ld(&bar[XB_XCNT(j)]); sum += c; cnt += (c > 0u) ? 1u : 0u; mine = (j == x) ? c : mine; }
        if (sum == G) break;
        __builtin_amdgcn_s_sleep(1);
        if ((++sp & 255u) == 0u) { if (xb_ld(&bar[XB_TMO])) break; if (sp > XB_SPIN_CAP) { atomicAdd(&bar[XB_TMO], 1u); break; } }
    }
    nloc = mine > 0u ? mine : 1u; nx = cnt > 0u ? cnt : 1u;
}
__device__ __forceinline__ void xcd_barrier(const XcdBarrier& b) {
    asm volatile("s_waitcnt vmcnt(0)" ::: "memory");
    __syncthreads();
    if (threadIdx.x == 0) {
        unsigned* bar = b.bar;
        __builtin_amdgcn_s_waitcnt(0);
        unsigned nloc = b.st[0], nx = b.st[1];
        if (nloc == 0u) { xcd_barrier_complete(bar, b.x, nloc, nx); b.st[0] = nloc; b.st[1] = nx; }
        const unsigned old = xb_add(&bar[XB_XSUB(b.x)], 1u);
        const unsigned gen = old / nloc;
        if (old + 1u == (gen + 1u) * nloc) {
            __builtin_amdgcn_fence(__ATOMIC_RELEASE, "agent");
            asm volatile("s_waitcnt vmcnt(0)" ::: "memory");
            const unsigned og = xb_add(&bar[XB_TOP], 1u);
            const unsigned tg = og / nx;
            if (og + 1u == (tg + 1u) * nx) xb_add(&bar[XB_TOPGEN], 1u);
            else XB_SPIN(xb_ld(&bar[XB_TOPGEN]) == tg, bar);
            __builtin_amdgcn_fence(__ATOMIC_ACQUIRE, "agent");
            xb_add(&bar[XB_XGEN(b.x)], 1u);
            asm volatile("s_waitcnt vmcnt(0)" ::: "memory");
        } else {
            XB_SPIN(xb_ld(&bar[XB_XGEN(b.x)]) == gen, bar);
            __builtin_amdgcn_fence(__ATOMIC_ACQUIRE, "agent");
            asm volatile("s_waitcnt vmcnt(0)" ::: "memory");
        }
    }
    __syncthreads();
}

__device__ __forceinline__ void topk_select(unsigned (&uk)[32], int t, unsigned* mrow, int lane, LAS unsigned* cb) {
    if (t + 1 <= TOPK) {
#pragma unroll 4
        for (int i = 0; i < 32; ++i) {
            const unsigned long long m = __ballot(64 * i + lane <= t);
            if (lane == 0) *(u32x2*)(mrow + 2 * i) = (u32x2){(unsigned)m, (unsigned)(m >> 32)};
        }
        return;
    }
#define TK_COUNT(cand_, cnt_) do { int c0_ = 0, c1_ = 0; \
        _Pragma("unroll") for (int i = 0; i < 32; i += 2) { c0_ += (uk[i] >= (cand_)) ? 1 : 0; c1_ += (uk[i + 1] >= (cand_)) ? 1 : 0; } \
        int c_ = c0_ + c1_; \
        c_ += __builtin_amdgcn_update_dpp(0, c_, 0xB1, 0xF, 0xF, false); c_ += __builtin_amdgcn_update_dpp(0, c_, 0x4E, 0xF, 0xF, false); \
        c_ += __builtin_amdgcn_update_dpp(0, c_, 0x141, 0xF, 0xF, false); c_ += __builtin_amdgcn_update_dpp(0, c_, 0x140, 0xF, 0xF, false); \
        cnt_ = __builtin_amdgcn_readlane(c_, 0) + __builtin_amdgcn_readlane(c_, 16) + __builtin_amdgcn_readlane(c_, 32) + __builtin_amdgcn_readlane(c_, 48); } while (0)
    unsigned M = 0u;
#pragma unroll
    for (int i = 0; i < 32; ++i) M = uk[i] > M ? uk[i] : M;
#pragma unroll
    for (int o = 1; o < 64; o <<= 1) { const unsigned v = (unsigned)__shfl_xor((int)M, o); M = v > M ? v : M; }
    M = (unsigned)__builtin_amdgcn_readfirstlane((int)M);
    unsigned T = 0u; bool exact = false; int bit = 31;
    int cnt_lo = 1 << 30, cnt_hi = 0;
#pragma unroll 1
    for (int nb = 8; nb >= 5; --nb) {
        const unsigned P = M & ~((1u << (32 - nb)) - 1u);
        int cnt; TK_COUNT(P, cnt);
        if (cnt >= TOPK) { T = P; bit = 31 - nb; cnt_lo = cnt; exact = (cnt == TOPK); break; }
    }
#pragma unroll 1
    for (; bit >= 0 && !exact && cnt_lo - cnt_hi > 64; --bit) {
        const unsigned cand = T | (1u << bit);
        int cnt; TK_COUNT(cand, cnt);
        if (cnt >= TOPK) { T = cand; cnt_lo = cnt; } else cnt_hi = cnt;
        if (cnt == TOPK) exact = true;
    }
#undef TK_COUNT
    if (!exact && bit >= 0) {
        const unsigned top = T >> (bit + 1);
        int base = 0;
#pragma unroll
        for (int i = 0; i < 32; ++i) {
            const bool al = (uk[i] >> (bit + 1)) == top;
            const unsigned long long m = __ballot(al);
            if (m) {
                if (al) cb[base + (int)__builtin_amdgcn_mbcnt_hi((unsigned)(m >> 32), __builtin_amdgcn_mbcnt_lo((unsigned)m, 0u))] = uk[i];
                base += __popcll(m);
            }
        }
        asm volatile("s_waitcnt lgkmcnt(0)" ::: "memory");
        const unsigned key = (lane < base) ? cb[lane] : 0u;
        const int r = TOPK - cnt_hi;
#pragma unroll 1
        for (int b = bit; b >= 0; --b) {
            const unsigned cand = T | (1u << b);
            if (__popcll(__ballot(key >= cand)) >= r) T = cand;
        }
        exact = (cnt_hi + __popcll(__ballot(key >= T)) == TOPK);
    }
    asm volatile("" : "+v"(T));
    if (exact) {
#pragma unroll
        for (int i = 0; i < 32; ++i) {
            const unsigned long long m = __ballot(uk[i] >= T);
            if (lane == 0) *(u32x2*)(mrow + 2 * i) = (u32x2){(unsigned)m, (unsigned)(m >> 32)};
        }
    } else {
        int cgt = 0;
#pragma unroll
        for (int i = 0; i < 32; ++i) cgt += __popcll(__ballot(uk[i] > T));
        int need = TOPK - cgt;
#pragma unroll 1
        for (int i = 0; i < 32; ++i) {
            unsigned ui = 0u;
#pragma unroll
            for (int q = 0; q < 32; ++q) ui = (q == i) ? uk[q] : ui;
            const unsigned long long gt = __ballot(ui > T);
            unsigned long long eq = __ballot(ui == T);
            int ce = __popcll(eq);
            while (ce > need) { eq &= ~(1ull << (63 - __clzll(eq))); --ce; }
            need -= ce;
            const unsigned long long m = gt | eq;
            if (lane == 0) *(u32x2*)(mrow + 2 * i) = (u32x2){(unsigned)m, (unsigned)(m >> 32)};
        }
    }
}

struct GmlpPar { const float* ln_v_g; const float* ln_v_b; const float* b_s; const float* out_norm_a_g; };
__device__ __forceinline__ void gmlp_unit(int un, const _Float16* UBl, const _Float16* VBl, const _Float16* GABl, const _Float16* WS16, const f32x2* VSTAT, unsigned char* Y, float* SSQA,
                                          const GmlpPar a, LAS unsigned char* lds, int tid, int lane, int wave) {
    LAS _Float16* vnT = (LAS _Float16*)lds;
    LAS float* sp = (LAS float*)(lds + 34816);
    LAS float* mu = (LAS float*)(lds + 34816 + 67584);
    const int r32 = lane & 31, hi = lane >> 5, tb = wave >> 1, chalf = wave & 1;
    const int hh = un & 15, nchk = (un >> 4) & 15, b = un >> 8;
    const int tok0 = b * SEQ + nchk * 128, c0 = hh * 128;
    const size_t tile = (size_t)((b * 16 + nchk) * 16 + hh) * 16384;
    const int tq = tid >> 5, cq = tid & 31;
    const int stt = tid >> 2, spart = tid & 3;
    f32x2 stv[8];
    { const f32x2* vp = VSTAT + (size_t)(tok0 + stt) * 32 + spart * 8;
#pragma unroll
      for (int q = 0; q < 8; ++q) stv[q] = vp[q]; }
    const int vcc = (tid & 15) * 8;
    h8 gvv[4];
#pragma unroll
    for (int p = 0; p < 4; ++p) gvv[p] = __builtin_nontemporal_load((const h8*)(VBl + tile + ((p * 512 + tid) >> 4) * 128 + vcc));
    const f32x4 lg0 = *(const f32x4*)(a.ln_v_g + c0 + vcc), lg1 = *(const f32x4*)(a.ln_v_g + c0 + vcc + 4);
    const f32x4 lb0 = *(const f32x4*)(a.ln_v_b + c0 + vcc), lb1 = *(const f32x4*)(a.ln_v_b + c0 + vcc + 4);
    h8 wfr[8];
    { const _Float16* wp = WS16 + ((size_t)hh * 128 + 32 * tb + r32) * 128 + 8 * hi;
#pragma unroll
      for (int kk = 0; kk < 8; ++kk) wfr[kk] = (kk <= 2 * tb + 1) ? *(const h8*)(wp + 16 * kk) : (h8){0, 0, 0, 0, 0, 0, 0, 0}; }
    h4 gu[8], gg[8]; float bsv[8];
#pragma unroll
    for (int i = 0; i < 8; ++i) { const int tt = tq * 8 + i; gu[i] = __builtin_nontemporal_load((const h4*)(UBl + tile + tt * 128 + 4 * cq)); gg[i] = __builtin_nontemporal_load((const h4*)(GABl + tile + tt * 128 + 4 * cq)); bsv[i] = a.b_s[hh * 128 + tt]; }
    const f32x4 og = *(const f32x4*)(a.out_norm_a_g + c0 + 4 * cq);
    __syncthreads();
    {
        float s1 = 0.f, s2 = 0.f;
#pragma unroll
        for (int q = 0; q < 8; ++q) { s1 += stv[q].x; s2 += stv[q].y; }
        s1 += __shfl_xor(s1, 1); s1 += __shfl_xor(s1, 2); s2 += __shfl_xor(s2, 1); s2 += __shfl_xor(s2, 2);
        const float mean = s1 * (1.0f / 2048.0f), var = fmaxf(s2 * (1.0f / 2048.0f) - mean * mean, 0.f);
        if (spart == 0) { mu[stt] = mean; mu[128 + stt] = 1.0f / sqrtf(var + EPS); }
    }
    __syncthreads();
#pragma unroll
    for (int p = 0; p < 4; ++p) {
        const int s_ = (p * 512 + tid) >> 4;
        const float m_ = mu[s_], r_ = mu[128 + s_];
#pragma unroll
        for (int q = 0; q < 4; ++q) {
            vnT[(vcc + q) * 136 + s_] = (_Float16)(((float)gvv[p][q] - m_) * r_ * lg0[q] + lb0[q]);
            vnT[(vcc + 4 + q) * 136 + s_] = (_Float16)(((float)gvv[p][4 + q] - m_) * r_ * lg1[q] + lb1[q]);
        }
    }
    __syncthreads();
    {
        f32x16 acc0, acc1;
#pragma unroll
        for (int r = 0; r < 16; ++r) { acc0[r] = 0.f; acc1[r] = 0.f; }
        const LAS _Float16* bp = vnT + (chalf * 64 + r32) * 136 + 8 * hi;
#pragma unroll
        for (int kk = 0; kk < 8; ++kk) {
            if (kk <= 2 * tb + 1) {
                const h8 b0 = *(const LAS h8*)(bp + 16 * kk), b1 = *(const LAS h8*)(bp + 32 * 136 + 16 * kk);
                acc0 = __builtin_amdgcn_mfma_f32_32x32x16_f16(wfr[kk], b0, acc0, 0, 0, 0);
                acc1 = __builtin_amdgcn_mfma_f32_32x32x16_f16(wfr[kk], b1, acc1, 0, 0, 0);
            }
        }
#pragma unroll
        for (int r = 0; r < 16; ++r) {
            const int tt = 32 * tb + (r & 3) + 8 * (r >> 2) + 4 * hi;
            sp[tt * 132 + chalf * 64 + r32] = acc0[r]; sp[tt * 132 + chalf * 64 + 32 + r32] = acc1[r];
        }
    }
    __syncthreads();
#pragma unroll
    for (int i = 0; i < 8; ++i) {
        const int tt = tq * 8 + i; const size_t row = (size_t)(tok0 + tt);
        const f32x4 spv = *(const LAS f32x4*)(sp + tt * 132 + 4 * cq);
        f32x4 y; float ss = 0.f;
#pragma unroll
        for (int q = 0; q < 4; ++q) { y[q] = (float)gu[i][q] * (spv[q] + bsv[i]); ss += y[q] * y[q]; y[q] = y[q] * og[q] * (float)gg[i][q]; }
#pragma unroll
        for (int o = 1; o < 32; o <<= 1) ss += __shfl_xor(ss, o);
        if (cq == 0) SSQA[row * 16 + hh] = ss;
        *(unsigned*)(Y + row * DM + c0 + 4 * cq) = pk_fp8x4(y[0] * Y8_SA, y[1] * Y8_SA, y[2] * Y8_SA, y[3] * Y8_SA);
    }
}

struct Args {
    const float* x; const float* c; const float* w_ada; const float* b_ada; const float* norm_g; const float* w_in; const float* ln_v_g; const float* ln_v_b;
    const float* w_s; const float* b_s; const float* q_norm_g; const float* k_norm_g; const float* rel_bias; const float* out_norm_a_g; const float* out_norm_b_g; const float* w_out;
    float* out; unsigned char* ws; int ph_lo, ph_hi;
};

__device__ __forceinline__ void p0_transpose_item(const float* W, int K, int N, _Float16* WT, LAS float* scr, int kb, int nb, int lane) {
    const int k0 = 64 * kb, n0 = 32 * nb;
    const int c = lane & 7;
    if (n0 >= N) {
#pragma unroll
        for (int j = 0; j < 4; ++j) { const int n = (lane >> 3) + 8 * j; *(u32x4*)(WT + (size_t)(n0 + n) * K + k0 + 8 * c) = (u32x4){0u, 0u, 0u, 0u}; }
        return;
    }
#pragma unroll 8
    for (int i = 0; i < 32; ++i) { const int kk = 2 * i + (lane >> 5); scr[kk * 33 + (lane & 31)] = __builtin_nontemporal_load(W + (size_t)(k0 + kk) * N + n0 + (lane & 31)); }
    asm volatile("s_waitcnt lgkmcnt(0)" ::: "memory");
#pragma unroll
    for (int j = 0; j < 4; ++j) { const int n = (lane >> 3) + 8 * j; const LAS float* s = scr + (8 * c) * 33 + n;
        u32x4 o; o.x = pk_h2(s[0 * 33], s[1 * 33]); o.y = pk_h2(s[2 * 33], s[3 * 33]); o.z = pk_h2(s[4 * 33], s[5 * 33]); o.w = pk_h2(s[6 * 33], s[7 * 33]);
        *(u32x4*)(WT + (size_t)(n0 + n) * K + k0 + 8 * c) = o; }
    asm volatile("s_waitcnt lgkmcnt(0)" ::: "memory");
}
__device__ __forceinline__ void p0_transpose_item_f8(const float* W, int K, int N, unsigned char* WT, LAS float* scr, int kb, int nb, int lane) {
    const int k0 = 64 * kb, n0 = 32 * nb;
    const int c = lane & 7;
#pragma unroll 8
    for (int i = 0; i < 32; ++i) { const int kk = 2 * i + (lane >> 5); scr[kk * 33 + (lane & 31)] = __builtin_nontemporal_load(W + (size_t)(k0 + kk) * N + n0 + (lane & 31)); }
    asm volatile("s_waitcnt lgkmcnt(0)" ::: "memory");
#pragma unroll
    for (int j = 0; j < 4; ++j) { const int n = (lane >> 3) + 8 * j; const LAS float* s = scr + (8 * c) * 33 + n;
        u32x2 o; o.x = pk_fp8x4(s[0 * 33] * W8_S, s[1 * 33] * W8_S, s[2 * 33] * W8_S, s[3 * 33] * W8_S); o.y = pk_fp8x4(s[4 * 33] * W8_S, s[5 * 33] * W8_S, s[6 * 33] * W8_S, s[7 * 33] * W8_S);
        *(u32x2*)(WT + (size_t)(n0 + n) * K + k0 + 8 * c) = o; }
    asm volatile("s_waitcnt lgkmcnt(0)" ::: "memory");
}

__global__ void __launch_bounds__(512, 2) fwd_kernel(Args a) {
    extern __shared__ __attribute__((aligned(16))) unsigned char lds_raw[];
    LAS unsigned char* lds = (LAS unsigned char*)lds_raw;
    cg::grid_group grid = cg::this_grid();
    const int tid = threadIdx.x, lane = tid & 63, wave = __builtin_amdgcn_readfirstlane(tid >> 6);
    const int G = gridDim.x, blk = blockIdx.x;
    const int gw = blk * 8 + wave, NGW = G * 8;
    unsigned char* ws = a.ws;
    _Float16* WTin = (_Float16*)(ws + WS_WTIN); unsigned char* WTout = ws + WS_WTOUT;
    _Float16* H = (_Float16*)(ws + WS_H); unsigned char* Y = ws + WS_Y;
    const _Float16* UBl = (const _Float16*)(ws + WS_U); const _Float16* VBl = (const _Float16*)(ws + WS_V); const _Float16* GABl = (const _Float16*)(ws + WS_GA);
    const _Float16* QBm = (const _Float16*)(ws + WS_QB); const _Float16* KBm = (const _Float16*)(ws + WS_KB); const _Float16* VVm = (const _Float16*)(ws + WS_VV);
    const _Float16* GBm = (const _Float16*)(ws + WS_GB); const _Float16* QIm = (const _Float16*)(ws + WS_QI); const _Float16* KIm = (const _Float16*)(ws + WS_KI);
    float* WI = (float*)(ws + WS_WI); float* MODP = (float*)(ws + WS_MODP); float* MOD = (float*)(ws + WS_MOD);
    f32x2* VSTAT = (f32x2*)(ws + WS_VSTAT); unsigned* MASK = (unsigned*)(ws + WS_MASK);
    float* SSQA = (float*)(ws + WS_SSQA); float* SSQB = (float*)(ws + WS_SSQB);
    const int lo = a.ph_lo, hi = a.ph_hi;
    const int gmlp_pre = (G == 256) ? 768 : 0;
#ifndef PHMASK
#define PHMASK 63
#endif
#define IN(k) (((PHMASK >> (k)) & 1) && lo <= (k) && (k) < hi)
    volatile LAS unsigned* xbw = (volatile LAS unsigned*)(lds + LDS_X + 8192);
    if (tid < 4) xbw[tid] = 0u;
    __syncthreads();
    const XcdBarrier xbar = xcd_barrier_post((unsigned*)ws, xbw);
    if (a.ph_lo < 0) grid.sync();
#define SEAM(k) do { if (IN(k) && IN((k) + 1)) xcd_barrier(xbar); } while (0)

    if (IN(0)) {
        LAS float* sc = (LAS float*)lds;
        for (int i = tid; i < NB * DM; i += 512) sc[i] = silu_f(a.c[i]);
        __syncthreads();
        LAS float* scr = (LAS float*)(lds + 65536 + wave * 8704);
        constexpr int N_ADA = 96 * KSPLIT;
        constexpr int N_TIN = 64 * (NZP / 32), N_TOUT = 64 * (DM / 32), N_WS = 16 * 128;
        for (int it = gw; it < N_ADA + N_TIN + N_TOUT + N_WS; it += NGW) {
            if (it < N_ADA) {
                const int jb = it % 96, ks = it / 96, j0 = jb * 128 + 2 * lane, k0 = ks * (DM / KSPLIT);
                f32x2 acc[NB];
#pragma unroll
                for (int b = 0; b < NB; ++b) acc[b] = (f32x2){0.f, 0.f};
                const float* wp = a.w_ada + (size_t)k0 * (3 * DM) + j0;
#pragma unroll 8
                for (int k = 0; k < DM / KSPLIT; ++k) {
                    const f32x2 w = __builtin_nontemporal_load((const f32x2*)(wp + (size_t)k * (3 * DM)));
#pragma unroll
                    for (int b = 0; b < NB; ++b) acc[b] += w * sc[b * DM + k0 + k];
                }
#pragma unroll
                for (int b = 0; b < NB; ++b) *(f32x2*)(MODP + ((size_t)ks * NB + b) * (3 * DM) + j0) = acc[b];
            } else if (it < N_ADA + N_TIN) {
                const int r = it - N_ADA; p0_transpose_item(a.w_in, DM, NZ, WTin, scr, r / (NZP / 32), r % (NZP / 32), lane);
            } else if (it < N_ADA + N_TIN + N_TOUT) {
                const int r = it - N_ADA - N_TIN; p0_transpose_item_f8(a.w_out, DM, DM, WTout, scr, r / (DM / 32), r % (DM / 32), lane);
            } else {
                const int r = it - N_ADA - N_TIN - N_TOUT, tt = r & 127;
                const f32x2 w = *(const f32x2*)(a.w_s + (size_t)r * 128 + 2 * lane);
                *(unsigned*)((_Float16*)(ws + WS_WS16) + (size_t)r * 128 + 2 * lane) = pk_h2(2 * lane <= tt ? w.x : 0.f, 2 * lane + 1 <= tt ? w.y : 0.f);
            }
        }
    }
    SEAM(0);

    if (IN(1)) {
        {
            const int per = (NB * 3 * DM) / G;
            for (int i = tid; i < per; i += 512) {
                const int e = blk * per + i, b = e / (3 * DM), j = e % (3 * DM);
                float s = a.b_ada[j];
                for (int ks = 0; ks < KSPLIT; ++ks) s += MODP[((size_t)ks * NB + b) * (3 * DM) + j];
                MOD[e] = s;
            }
        }
        const int rows_per = NT / G;
        const int b = (blk * rows_per) / SEQ;
        LAS float* sh = (LAS float*)lds;
#pragma unroll 1
        for (int j4 = tid; j4 < 2 * DM / 4; j4 += 512) {
            f32x4 pv[KSPLIT];
#pragma unroll
            for (int ks = 0; ks < KSPLIT; ++ks) pv[ks] = *(const f32x4*)(MODP + ((size_t)ks * NB + b) * (3 * DM) + 4 * j4);
            f32x4 s4 = *(const f32x4*)(a.b_ada + 4 * j4);
#pragma unroll
            for (int ks = 0; ks < KSPLIT; ++ks) s4 += pv[ks];
            if (4 * j4 >= DM) s4 = (s4 + 1.0f) * *(const f32x4*)(a.norm_g + 4 * j4 - DM);
            *(LAS f32x4*)(sh + 4 * j4) = s4;
        }
        __syncthreads();
#pragma unroll 1
        for (int r = wave; r < rows_per; r += 8) {
            const int row = blk * rows_per + r;
            asm volatile("" ::: "memory");
            const f32x4* xr = (const f32x4*)(a.x + (size_t)row * DM) + lane;
            f32x4 v[16]; float ss = 0.f;
#pragma unroll
            for (int j = 0; j < 16; ++j) { v[j] = __builtin_nontemporal_load(xr + 64 * j); ss += (v[j].x * v[j].x + v[j].y * v[j].y) + (v[j].z * v[j].z + v[j].w * v[j].w); }
            const float rstd = 1.0f / sqrtf(wave_sum(ss) * (1.0f / DM) + EPS);
            u32x2* o8 = (u32x2*)(H + (size_t)row * DM) + lane;
#pragma unroll
            for (int j = 0; j < 16; ++j) {
                const int col = 256 * j + 4 * lane;
                const f32x4 sf = *(const LAS f32x4*)(sh + col), sc = *(const LAS f32x4*)(sh + DM + col);
                const f32x4 hv = v[j] * rstd * sc + sf;
                u32x2 w; w.x = pk_h2(hv.x, hv.y); w.y = pk_h2(hv.z, hv.w); o8[64 * j] = w;
                if ((j & 3) == 3) asm volatile("" ::: "memory");
            }
        }
    }
    SEAM(1);

    if (IN(2)) {
        pg8::Gemm g{H, WTin, NT, NZP, DM}; pg8::StaticOrder S; S.init(NT, NZP, G, blk);
        unsigned* done5 = (unsigned*)ws + XCD_BAR_WORDS;
        EpiZ E{ws, WI, VSTAT, done5};
        pg8::gemm_phase<EpiZ>(lds, g, S, E);
        if (gmlp_pre > 0 && blk >= G - gmlp_pre / 8) {
            if (tid == 0) {
                unsigned sp_ = 0;
                while (__hip_atomic_load(done5, __ATOMIC_RELAXED, __HIP_MEMORY_SCOPE_AGENT) < (unsigned)G) { __builtin_amdgcn_s_sleep(2); if (++sp_ > (1u << 22)) break; }
                __builtin_amdgcn_fence(__ATOMIC_ACQUIRE, "agent");
                asm volatile("s_waitcnt vmcnt(0)" ::: "memory");
            }
            __syncthreads();
            const GmlpPar gp{a.ln_v_g, a.ln_v_b, a.b_s, a.out_norm_a_g};
            const int u0 = (blk - (G - gmlp_pre / 8)) * 8;
            for (int k = 0; k < 8; ++k) gmlp_unit(u0 + k, UBl, VBl, GABl, (const _Float16*)(ws + WS_WS16), VSTAT, Y, SSQA, gp, lds, tid, lane, wave);
        }
    }
    SEAM(2);

    if (IN(3)) {
        {
            _Float16* KNw = (_Float16*)(ws + WS_KN);
            constexpr int KN_IT = NT / 2048;
            int lane_k = lane; asm volatile("" : "+v"(lane_k));
            h8 kv[KN_IT];
#pragma unroll
            for (int i = 0; i < KN_IT; ++i) { const int tok = gw + i * NGW; kv[i] = (tok < NT) ? __builtin_nontemporal_load((const h8*)(KBm + (size_t)tok * 512 + 8 * lane_k)) : (h8){0, 0, 0, 0, 0, 0, 0, 0}; }
#pragma unroll
            for (int i = 0; i < KN_IT; ++i) {
                const int tok = gw + i * NGW;
                float f[8], ss = 0.f;
#pragma unroll
                for (int j = 0; j < 8; ++j) { f[j] = (float)kv[i][j]; ss += f[j] * f[j]; }
                ss += __shfl_xor(ss, 1); ss += __shfl_xor(ss, 2); ss += __shfl_xor(ss, 4); ss += __shfl_xor(ss, 8);
                const float rk = 1.0f / sqrtf(ss * (1.0f / 128.0f) + EPS);
                u32x4 w; w.x = pk_h2(f[0] * rk, f[1] * rk); w.y = pk_h2(f[2] * rk, f[3] * rk); w.z = pk_h2(f[4] * rk, f[5] * rk); w.w = pk_h2(f[6] * rk, f[7] * rk);
                if (tok < NT) *(u32x4*)(KNw + (size_t)tok * 512 + 8 * lane_k) = w;
            }
            for (int tok = gw + KN_IT * NGW; tok < NT; tok += NGW) {
                const h8 k8 = *(const h8*)(KBm + (size_t)tok * 512 + 8 * lane_k);
                float f[8], ss = 0.f;
#pragma unroll
                for (int j = 0; j < 8; ++j) { f[j] = (float)k8[j]; ss += f[j] * f[j]; }
                ss += __shfl_xor(ss, 1); ss += __shfl_xor(ss, 2); ss += __shfl_xor(ss, 4); ss += __shfl_xor(ss, 8);
                const float rk = 1.0f / sqrtf(ss * (1.0f / 128.0f) + EPS);
                u32x4 w; w.x = pk_h2(f[0] * rk, f[1] * rk); w.y = pk_h2(f[2] * rk, f[3] * rk); w.z = pk_h2(f[4] * rk, f[5] * rk); w.w = pk_h2(f[6] * rk, f[7] * rk);
                *(u32x4*)(KNw + (size_t)tok * 512 + 8 * lane_k) = w;
            }
        }
        {
            LAS unsigned char* ring = lds;
            LAS float* scw = (LAS float*)(lds + 65536) + wave * SEQ;
            const int r32 = lane & 31, hi = lane >> 5;
            unsigned voffI[2];
#pragma unroll
            for (int i = 0; i < 2; ++i) { const int Gn = (wave * 2 + i) * 64 + lane, row = Gn >> 4, cg = (Gn & 15) ^ (row & 15); voffI[i] = (unsigned)(row * 128 + cg * 8); }
            for (int un = blk; un < 512; un += G) {
                const int jj = un & 255, b = 2 * (jj >> 7) + (un >> 8), qb = (un >> 8) ? 127 - (jj & 127) : (jj & 127);
                const int q0 = 16 * qb, tA = q0 + 2 * wave, tB = tA + 1;
                const int ngr = (q0 + 15) / 64 + 1;
                const size_t tokA = (size_t)b * SEQ + tA;
                const _Float16* kib = KIm + (size_t)b * SEQ * 128;
                h8 qaA[8], qaB[8]; float wA[16], wB[16];
                {
                    int r32_p = r32, hi_p = hi; asm volatile("" : "+v"(r32_p), "+v"(hi_p));
                    const _Float16* qp = QIm + tokA * 4096 + r32_p * 128 + 8 * hi_p;
#pragma unroll
                    for (int kk = 0; kk < 8; ++kk) { qaA[kk] = __builtin_nontemporal_load((const h8*)(qp + 16 * kk)); qaB[kk] = __builtin_nontemporal_load((const h8*)(qp + 4096 + 16 * kk)); }
                    const float* wp = WI + tokA * 32 + 4 * hi_p;
#pragma unroll
                    for (int r = 0; r < 16; ++r) { wA[r] = wp[(r & 3) + 8 * (r >> 2)]; wB[r] = wp[32 + (r & 3) + 8 * (r >> 2)]; }
                }
                float scB[32];
#pragma unroll
                for (int i = 0; i < 32; ++i) scB[i] = 0.f;
                __syncthreads();
#define IDX_DMA(c_) do { _Pragma("unroll") for (int i_ = 0; i_ < 2; ++i_) \
        __builtin_amdgcn_global_load_lds((const unsigned*)(kib + (size_t)(64 * (c_)) * 128 + voffI[i_]), (LAS unsigned*)(ring + ((c_) & 3) * 16384 + (wave * 2 + i_) * 1024), 16, 0, 0); } while (0)
                IDX_DMA(0); if (1 < ngr) IDX_DMA(1); if (2 < ngr) IDX_DMA(2);
                const bool grpY = wave >= 4;
                f32x16 aA0, aB0, aA1, aB1;
                int cpend = -1;
#define IDX_EPI(cc_) do { \
                    float sa = 0.f, sb = 0.f, sc1 = 0.f, sd = 0.f; \
                    _Pragma("unroll") for (int r = 0; r < 16; ++r) {     \
                        sa = __builtin_fmaf(wA[r], relu1(aA0[r]), sa); sb = __builtin_fmaf(wB[r], relu1(aB0[r]), sb); \
                        sc1 = __builtin_fmaf(wA[r], relu1(aA1[r]), sc1); sd = __builtin_fmaf(wB[r], relu1(aB1[r]), sd); } \
                      \
                    const float mineA = (lane < 32) ? sa : sc1, othA = (lane < 32) ? sc1 : sa; \
                    const float mineB = (lane < 32) ? sb : sd, othB = (lane < 32) ? sd : sb; \
                    const float totA = mineA + __shfl_xor(othA, 32), totB = mineB + __shfl_xor(othB, 32); \
                    scw[64 * (cc_) + lane] = totA; \
                    _Pragma("unroll") for (int i = 0; i < 32; ++i) scB[i] = (i == (cc_)) ? totB : scB[i]; \
                } while (0)
#pragma unroll 1
                for (int c = 0; c < ngr; ++c) {
                    const int rem = ngr - 1 - c;
                    if (rem >= 2) asm volatile("s_waitcnt vmcnt(4)" ::: "memory"); else if (rem == 1) asm volatile("s_waitcnt vmcnt(2)" ::: "memory"); else asm volatile("s_waitcnt vmcnt(0)" ::: "memory");
                    __builtin_amdgcn_s_barrier();
                    asm volatile("" ::: "memory");
                    if (c + 3 < ngr) IDX_DMA(c + 3);
                    if (grpY && cpend >= 0) { IDX_EPI(cpend); cpend = -1; }
                    if (64 * c <= tB) {
                        const LAS unsigned char* rb = ring + (c & 3) * 16384;
                        const LAS unsigned char* rp0 = rb + r32 * 256;
                        h8 f0[8], f1[8];
#pragma unroll
                        for (int kk = 0; kk < 8; ++kk) { f0[kk] = *(const LAS h8*)(rp0 + (((2 * kk + hi) ^ (r32 & 15)) << 4)); f1[kk] = *(const LAS h8*)(rp0 + 8192 + (((2 * kk + hi) ^ (r32 & 15)) << 4)); }
#pragma unroll
                        for (int r = 0; r < 16; ++r) { aA0[r] = 0.f; aB0[r] = 0.f; aA1[r] = 0.f; aB1[r] = 0.f; }
                        __builtin_amdgcn_s_setprio(1);
#pragma unroll
                        for (int kk = 0; kk < 8; ++kk) {
                            aA0 = __builtin_amdgcn_mfma_f32_32x32x16_f16(qaA[kk], f0[kk], aA0, 0, 0, 0);
                            aB0 = __builtin_amdgcn_mfma_f32_32x32x16_f16(qaB[kk], f0[kk], aB0, 0, 0, 0);
                        }
#pragma unroll
                        for (int kk = 0; kk < 8; ++kk) {
                            aA1 = __builtin_amdgcn_mfma_f32_32x32x16_f16(qaA[kk], f1[kk], aA1, 0, 0, 0);
                            aB1 = __builtin_amdgcn_mfma_f32_32x32x16_f16(qaB[kk], f1[kk], aB1, 0, 0, 0);
                        }
                        __builtin_amdgcn_s_setprio(0);
                        if (grpY) cpend = c; else IDX_EPI(c);
                    }
                }
                if (grpY && cpend >= 0) IDX_EPI(cpend);
#undef IDX_EPI
#undef IDX_DMA
                {
                    unsigned uk[32];
                    int lane_o = lane; asm volatile("" : "+v"(lane_o));
                    const LAS float* sl = scw + lane_o;
#pragma unroll
                    for (int i = 0; i < 32; ++i) { const unsigned bits = __float_as_uint(sl[64 * i]); uk[i] = (64 * i + lane_o <= tA) ? ((bits & 0x80000000u) ? ~bits : (bits | 0x80000000u)) : 0u; }
                    asm volatile("s_waitcnt lgkmcnt(0)" ::: "memory");
                    topk_select(uk, tA, MASK + tokA * 64, lane_o, (LAS unsigned*)scw);
#pragma unroll
                    for (int i = 0; i < 32; ++i) { const unsigned bits = __float_as_uint(scB[i]); uk[i] = (64 * i + lane_o <= tB) ? ((bits & 0x80000000u) ? ~bits : (bits | 0x80000000u)) : 0u; }
                    topk_select(uk, tB, MASK + (tokA + 1) * 64, lane_o, (LAS unsigned*)scw);
                }
            }
        }
        __syncthreads();
        {
            const GmlpPar gp{a.ln_v_g, a.ln_v_b, a.b_s, a.out_norm_a_g};
            for (int un = gmlp_pre + blk; un < NB * 16 * 16; un += G) gmlp_unit(un, UBl, VBl, GABl, (const _Float16*)(ws + WS_WS16), VSTAT, Y, SSQA, gp, lds, tid, lane, wave);
        }
    }
    SEAM(3);

    if (IN(4)) {
        using namespace att;
        const int r32 = lane & 31, hi = lane >> 5, hr = wave & 3, qh = wave >> 2;
        LAS unsigned char* V_lds = lds + L_V; LAS unsigned char* K_lds = lds + L_K;
        LAS unsigned* mask_l = (LAS unsigned*)(lds + L_MSK); LAS float* li_l = (LAS float*)(lds + L_LI) + wave * 32;
        LAS float* dtab = (LAS float*)(lds + L_DT); LAS int* bucket = (LAS int*)(lds + L_BK);
        const _Float16* KN = (const _Float16*)(ws + WS_KN);
        const int vb0 = (int)(uintptr_t)V_lds + v_rd_base(lane);
        unsigned voffV[2], voffK[2];
#pragma unroll
        for (int i = 0; i < 2; ++i) {
            const int Gn = (wave * 2 + i) * 64 + lane;
            const int kk = ((Gn >> 7) << 3) | ((Gn >> 2) & 7), c = ((Gn >> 5) & 3) * 32 + (Gn & 3) * 8;
            const int k = (kk & ~0xC) | ((kk & 4) << 1) | ((kk & 8) >> 1);
            voffV[i] = (unsigned)(k * 512 + c);
            const int row = Gn >> 4, cg = (Gn & 15) ^ (row & 7);
            voffK[i] = (unsigned)(row * 512 + cg * 8);
        }
        LAS float* gqk_l = (LAS float*)(lds + L_GQK); LAS float* rb_l = (LAS float*)(lds + L_RB);
        if (tid < 128) {
            const int n = tid; int bk;
            if (n < 16) bk = n; else { bk = 16 + (int)(logf((float)n / 16.0f) / 2.0794415416798357f * 16.0f); bk = bk < 31 ? bk : 31; }
            bucket[n] = bk;
            gqk_l[n] = a.q_norm_g[n] * a.k_norm_g[n] * (1.44269504089f * 0.08838834764831845f);
        }
        rb_l[tid] = a.rel_bias[tid];
        for (int cu0 = blk; cu0 < 256; cu0 += G) {
            const int cu = (G == 256) ? (((cu0 & 7) * 2 + (cu0 >> 7)) * 16 + ((cu0 >> 3) & 15)) : cu0;
            const int bg = cu >> 4, b = bg >> 2, g = bg & 3, ci = cu & 15;
            const int h = 4 * g + hr;
            __syncthreads();
            int tid_o = tid; asm volatile("" : "+v"(tid_o));
            for (int i = tid_o; i < 1024; i += 512) {
                const int hh = i >> 8, dist = (i & 255) - 64;
                float v = 0.f;
                if (dist >= 0 && dist < 113) v = (rb_l[bucket[dist] * 16 + 4 * g + hh] - rb_l[31 * 16 + 4 * g + hh]) * 1.44269504089f;
                dtab[i] = v;
            }
            const _Float16* Kh = KN + (size_t)b * SEQ * 512 + g * 128; const _Float16* Vh = VVm + (size_t)b * SEQ * 512 + g * 128;
#pragma unroll 1
            for (int uu = 0; uu < 2; ++uu) {
                const int qb = uu == 0 ? (31 - ci) : ci;
                const int NTL = qb + 1;
                const int ql = 32 * qh + r32, t = 64 * qb + ql;
#define ATT_DMA(bf, k0) do { _Pragma("unroll") for (int i_ = 0; i_ < 2; ++i_) { \
        __builtin_amdgcn_global_load_lds((const unsigned*)(Vh + (size_t)(k0) * 512 + voffV[i_]), (LAS unsigned*)(V_lds + (bf) * 16384 + (wave * 2 + i_) * 1024), 16, 0, 0); \
        __builtin_amdgcn_global_load_lds((const unsigned*)(Kh + (size_t)(k0) * 512 + voffK[i_]), (LAS unsigned*)(K_lds + (bf) * 16384 + (wave * 2 + i_) * 1024), 16, 0, 0); } } while (0)
                __syncthreads();
                ATT_DMA(0, 0);
                {
                    const unsigned* mg = MASK + ((size_t)b * SEQ + 64 * qb) * 64;
                    int tid_m = tid; asm volatile("" : "+v"(tid_m));
#pragma unroll
                    for (int p = 0; p < 2; ++p) { const int e = p * 512 + tid_m; const u32x4 w = *(const u32x4*)(mg + e * 4); const int q = e >> 4, wq = (e & 15) * 4;
                        LAS unsigned* d = mask_l + q * 66 + wq; *(LAS u32x2*)d = (u32x2){w.x, w.y}; *(LAS u32x2*)(d + 2) = (u32x2){w.z, w.w}; }
                }
                h8 qr[8];
                {
                    int hi_p = hi, t_p = t; asm volatile("" : "+v"(hi_p), "+v"(t_p));
                    const _Float16* qp = QBm + ((size_t)b * SEQ + t_p) * 2048 + h * 128 + 8 * hi_p;
                    float ss = 0.f;
#pragma unroll
                    for (int d0 = 0; d0 < 8; ++d0) { qr[d0] = __builtin_nontemporal_load((const h8*)(qp + 16 * d0));
#pragma unroll
                        for (int j = 0; j < 8; ++j) { const float f = (float)qr[d0][j]; ss += f * f; } }
                    ss += __shfl_xor(ss, 32);
                    const float rs = 1.0f / sqrtf(ss * (1.0f / 128.0f) + EPS);
#pragma unroll
                    for (int d0 = 0; d0 < 8; ++d0) {
                        const f32x4 g0 = *(const LAS f32x4*)(gqk_l + 16 * d0 + 8 * hi_p), g1 = *(const LAS f32x4*)(gqk_l + 16 * d0 + 8 * hi_p + 4);
                        h8 o8;
#pragma unroll
                        for (int j = 0; j < 4; ++j) { o8[j] = (_Float16)((float)qr[d0][j] * rs * g0[j]); o8[4 + j] = (_Float16)((float)qr[d0][4 + j] * rs * g1[j]); }
                        qr[d0] = o8;
                    }
                }
                f32x16 o[4];
#pragma unroll
                for (int d = 0; d < 4; ++d)
#pragma unroll
                    for (int r = 0; r < 16; ++r) o[d][r] = 0.f;
                float lsum = 0.f;
                const LAS unsigned* mq = mask_l + ql * 66;
                __syncthreads();
#define ATT_PK4(P, BASE, OUT) do { unsigned a0 = cvtpk_bf16(P[BASE + 0], P[BASE + 1]), a1 = cvtpk_bf16(P[BASE + 2], P[BASE + 3]); \
        unsigned b0 = cvtpk_bf16(P[BASE + 4], P[BASE + 5]), b1 = cvtpk_bf16(P[BASE + 6], P[BASE + 7]); \
        auto r0 = __builtin_amdgcn_permlane32_swap(a0, b0, false, false); auto r1 = __builtin_amdgcn_permlane32_swap(a1, b1, false, false); \
        u32x4 w = {r0[0], r1[0], r0[1], r1[1]}; OUT = __builtin_bit_cast(bf16x8, w); } while (0)
#define ATT_TILE(BF, J) do { \
                    const int j_ = (J); \
                    if (j_ + 1 < NTL) ATT_DMA((BF) ^ 1, 64 * (j_ + 1)); \
                    f32x16 p0, p1; \
                    qkt(p0, p1, K_lds + (BF) * 16384, qr, r32, hi); \
                    { \
                        const u32x2 mw = *(const LAS u32x2*)(mq + 2 * j_); \
                        const unsigned w0 = mw.x >> (4 * hi), w1 = mw.y >> (4 * hi); \
                        if (j_ >= NTL - 3) { \
                            const LAS float* dt = dtab + hr * 256 + (t - 64 * j_ + 64 - 4 * hi - 63); \
                            _Pragma("unroll") for (int r = 0; r < 16; ++r) { const int c = (r & 3) + 8 * (r >> 2); p0[r] += dt[63 - c]; p1[r] += dt[63 - c - 32]; } \
                        } \
                        _Pragma("unroll") for (int r = 0; r < 16; ++r) { \
                            const int c = (r & 3) + 8 * (r >> 2); \
                            const float e0 = __builtin_amdgcn_exp2f(p0[r]), e1 = __builtin_amdgcn_exp2f(p1[r]); \
                            p0[r] = ((w0 >> c) & 1u) ? e0 : 0.f; p1[r] = ((w1 >> c) & 1u) ? e1 : 0.f; \
                            lsum += p0[r] + p1[r]; \
                        } \
                    } \
                    bf16x8 pa0, pa1, pa2, pa3; \
                    ATT_PK4(p0, 0, pa0); ATT_PK4(p0, 8, pa1); ATT_PK4(p1, 0, pa2); ATT_PK4(p1, 8, pa3); \
                    ATT_SBAR(); \
                    const int vb = vb0 + (BF) * 16384; \
                    pv_one<0>(o[0], vb, pa0, pa1, pa2, pa3); pv_one<1>(o[1], vb, pa0, pa1, pa2, pa3); pv_one<2>(o[2], vb, pa0, pa1, pa2, pa3); pv_one<3>(o[3], vb, pa0, pa1, pa2, pa3); \
                    __syncthreads(); \
                } while (0)
                {
                    int j = 0;
#pragma unroll 1
                    for (; j + 1 < NTL; j += 2) { ATT_TILE(0, j); ATT_TILE(1, j + 1); }
                    if (j < NTL) ATT_TILE(0, j);
                }
#undef ATT_TILE
                int t_e = 64 * qb + 32 * qh, r32_e = r32, hi_e = hi; asm volatile("" : "+v"(t_e), "+v"(r32_e), "+v"(hi_e));
                lsum += __shfl_xor(lsum, 32);
                if (hi_e == 0) li_l[r32_e] = lsum;
                asm volatile("s_waitcnt lgkmcnt(0)" ::: "memory");
                LAS _Float16* ot = (LAS _Float16*)(lds + L_V) + wave * 4096;
#pragma unroll
                for (int r = 0; r < 16; ++r) {
                    const int qrow = crow(r, hi_e);
                    const float rl = __builtin_amdgcn_rcpf(li_l[qrow]);
                    float ssq = 0.f;
#pragma unroll
                    for (int d0 = 0; d0 < 4; ++d0) { const float ov = o[d0][r] * rl; ssq += ov * ov; ot[qrow * 128 + 32 * d0 + r32_e] = (_Float16)ov; }
#pragma unroll
                    for (int of = 1; of < 32; of <<= 1) ssq += __shfl_xor(ssq, of);
                    if (r32_e == 0) SSQB[((size_t)b * SEQ + t_e + qrow) * 16 + h] = ssq;
                }
                asm volatile("s_waitcnt lgkmcnt(0)" ::: "memory");
                {
                    int lane_e = lane; asm volatile("" : "+v"(lane_e));
                    const int c16 = lane_e & 15, qs = lane_e >> 4;
                    const f32x4 og0 = *(const f32x4*)(a.out_norm_b_g + h * 128 + 8 * c16) * Y8_SB, og1 = *(const f32x4*)(a.out_norm_b_g + h * 128 + 8 * c16 + 4) * Y8_SB;
#pragma unroll
                    for (int hf = 0; hf < 2; ++hf) {
                    h8 gbv[4], ovv[4];
#pragma unroll
                    for (int i = 0; i < 4; ++i) {
                        const int q = qs + 4 * (4 * hf + i); const size_t tk = (size_t)b * SEQ + t_e + q;
                        gbv[i] = __builtin_nontemporal_load((const h8*)(GBm + tk * 2048 + h * 128 + 8 * c16));
                        ovv[i] = *(const LAS h8*)(ot + q * 128 + 8 * c16);
                    }
#pragma unroll
                    for (int i = 0; i < 4; ++i) {
                        const int q = qs + 4 * (4 * hf + i); const size_t tk = (size_t)b * SEQ + t_e + q;
                        u32x2 w;
                        w.x = pk_fp8x4((float)ovv[i][0] * og0[0] * (float)gbv[i][0], (float)ovv[i][1] * og0[1] * (float)gbv[i][1], (float)ovv[i][2] * og0[2] * (float)gbv[i][2], (float)ovv[i][3] * og0[3] * (float)gbv[i][3]);
                        w.y = pk_fp8x4((float)ovv[i][4] * og1[0] * (float)gbv[i][4], (float)ovv[i][5] * og1[1] * (float)gbv[i][5], (float)ovv[i][6] * og1[2] * (float)gbv[i][6], (float)ovv[i][7] * og1[3] * (float)gbv[i][7]);
                        *(u32x2*)(Y + tk * DM + 2048 + h * 128 + 8 * c16) = w;
                    }
                    asm volatile("" ::: "memory");
                    }
                }
#undef ATT_DMA
#undef ATT_PK4
            }
        }
    }
    SEAM(4);

    if (IN(5)) {
        pg8::Gemm g{Y, WTout, NT, DM, DM}; pg8::StaticOrder S; S.init(NT, DM, G, blk);
        EpiOut E{a.x, a.out, MOD, SSQA, SSQB};
        pg8::gemm_phase<EpiOut, true, true, true>(lds, g, S, E);
    }
#undef IN
#undef SEAM
}

extern "C" void kernel_launch(void* const* d_in, const int* in_sizes, int n_in, void* d_out, int out_size, void* d_ws, size_t ws_size, hipStream_t stream) {
    static int grid = 0;
    if (grid == 0) {
        if (n_in != 16 || out_size != NT * DM || ws_size < WS_END) { fprintf(stderr, "kernel_launch: unexpected shapes (n_in %d out %d ws %zu)\n", n_in, out_size, ws_size); grid = -1; return; }
        int dev = 0, cus = 0, per_cu = 0;
        hipGetDevice(&dev);
        hipDeviceGetAttribute(&cus, hipDeviceAttributeMultiprocessorCount, dev);
        hipFuncSetAttribute((const void*)fwd_kernel, hipFuncAttributeMaxDynamicSharedMemorySize, LDS_BYTES);
        hipOccupancyMaxActiveBlocksPerMultiprocessor(&per_cu, (const void*)fwd_kernel, 512, LDS_BYTES);
        if (per_cu < 1) { fprintf(stderr, "kernel_launch: occupancy query says %d blocks per CU\n", per_cu); grid = -1; return; }
        grid = cus;
        if (grid > 256) grid = 256;
        (void)hipGetLastError();
    }
    if (grid < 0) return;
    Args a{};
    a.x = (const float*)d_in[0]; a.c = (const float*)d_in[1]; a.w_ada = (const float*)d_in[2]; a.b_ada = (const float*)d_in[3]; a.norm_g = (const float*)d_in[4];
    a.w_in = (const float*)d_in[5]; a.ln_v_g = (const float*)d_in[6]; a.ln_v_b = (const float*)d_in[7]; a.w_s = (const float*)d_in[8]; a.b_s = (const float*)d_in[9];
    a.q_norm_g = (const float*)d_in[10]; a.k_norm_g = (const float*)d_in[11]; a.rel_bias = (const float*)d_in[12]; a.out_norm_a_g = (const float*)d_in[13];
    a.out_norm_b_g = (const float*)d_in[14]; a.w_out = (const float*)d_in[15];
    a.out = (float*)d_out; a.ws = (unsigned char*)d_ws; a.ph_lo = 0; a.ph_hi = 6;
    (void)hipMemsetAsync(d_ws, 0, XCD_BAR_WORDS * 4 + 256, stream);
    void* args[] = {&a};
    hipError_t e = hipLaunchCooperativeKernel((const void*)fwd_kernel, dim3(grid), dim3(512), args, LDS_BYTES, stream);
    if (e != hipSuccess) fprintf(stderr, "kernel_launch: cooperative launch failed: %s (grid %d)\n", hipGetErrorString(e), grid);
}
```

```cpp
#include <hip/hip_runtime.h>
#include <hip/hip_cooperative_groups.h>
#include <cstdio>
#include <cstdint>
namespace cg = cooperative_groups;

#define LAS __attribute__((address_space(3)))
typedef _Float16 h8 __attribute__((ext_vector_type(8)));
typedef _Float16 h4 __attribute__((ext_vector_type(4)));
typedef _Float16 h2 __attribute__((ext_vector_type(2)));
typedef float f32x2 __attribute__((ext_vector_type(2)));
typedef float f32x4 __attribute__((ext_vector_type(4)));
typedef float f32x16 __attribute__((ext_vector_type(16)));
typedef unsigned u32x2 __attribute__((ext_vector_type(2)));
typedef unsigned u32x4 __attribute__((ext_vector_type(4)));

constexpr int NB = 4, SEQ = 2048, DM = 4096, NT = NB * SEQ;
constexpr int NZ = 15520, NZP = 15616;
constexpr int C_U = 0, C_V = 2048, C_GA = 4096, C_QB = 6144, C_KB = 8192, C_VB = 8704, C_GB = 9216, C_QI = 11264, C_KI = 15360, C_WI = 15488;
constexpr float EPS = 1e-6f;
constexpr int TOPK = 256;
constexpr int KSPLIT = 16;

constexpr size_t MiB = 1u << 20;
constexpr size_t WS_WTIN = 1 * MiB;
constexpr size_t WS_WTOUT = 123 * MiB;
constexpr size_t WS_W8IN = 547 * MiB;
constexpr size_t WS_H = 155 * MiB;
constexpr size_t WS_U = 219 * MiB;
constexpr size_t WS_V = 251 * MiB;
constexpr size_t WS_GA = 283 * MiB;
constexpr size_t WS_QB = 315 * MiB;
constexpr size_t WS_KB = 347 * MiB;
constexpr size_t WS_VV = 355 * MiB;
constexpr size_t WS_GB = 363 * MiB;
constexpr size_t WS_QI = 395 * MiB;
constexpr size_t WS_KI = 459 * MiB;
constexpr size_t WS_WI = 463 * MiB;
constexpr size_t WS_MODP = 464 * MiB;
constexpr size_t WS_MOD = 467 * MiB;
constexpr size_t WS_VSTAT = 468 * MiB;
constexpr size_t WS_MASK = 470 * MiB;
constexpr size_t WS_Y = 472 * MiB;
constexpr size_t WS_H8 = 504 * MiB;
constexpr size_t WS_SSQA = 536 * MiB;
constexpr size_t WS_SSQB = 537 * MiB;
constexpr size_t WS_KN = 538 * MiB;
constexpr size_t WS_WS16 = 546 * MiB;
constexpr size_t WS_END = 571 * MiB;

constexpr int LDS_BYTES = 147456;
constexpr int LDS_X = 131072;

template <int CTRL> __device__ __forceinline__ float dpp_mov(float x) { return __int_as_float(__builtin_amdgcn_update_dpp(0, __float_as_int(x), CTRL, 0xF, 0xF, false)); }
__device__ __forceinline__ float sum4(float x) { x += dpp_mov<0xB1>(x); x += dpp_mov<0x4E>(x); return x; }
__device__ __forceinline__ float sum16(float x) { x = sum4(x); x += dpp_mov<0x141>(x); x += dpp_mov<0x140>(x); return x; }
__device__ __forceinline__ float xsum16(float x) { const auto r = __builtin_amdgcn_permlane16_swap(__float_as_uint(x), __float_as_uint(x), false, false); return __uint_as_float(r[0]) + __uint_as_float(r[1]); }
__device__ __forceinline__ float xsum32(float x) { const auto r = __builtin_amdgcn_permlane32_swap(__float_as_uint(x), __float_as_uint(x), false, false); return __uint_as_float(r[0]) + __uint_as_float(r[1]); }
__device__ __forceinline__ float sum32(float x) { return xsum16(sum16(x)); }
__device__ __forceinline__ float wave_sum(float v) { return xsum32(sum32(v)); }
__device__ __forceinline__ float wave_max(float v) {
#pragma unroll
    for (int o = 1; o < 64; o <<= 1) v = fmaxf(v, __shfl_xor(v, o));
    return v;
}
constexpr float Y8_SA = 8.f, Y8_SB = 32.f, W8_S = 256.f, H8_S = 16.f;
constexpr int F8LO = 0, F8HI = 21, F8N = F8HI - F8LO;
constexpr int GM_UPI = 6;
__device__ __forceinline__ float clamp448(float v) { return __builtin_amdgcn_fmed3f(v, -448.f, 448.f); }
__device__ __forceinline__ unsigned pk_fp8x4(float a, float b, float c, float d) {
    int r = __builtin_amdgcn_cvt_pk_fp8_f32(clamp448(a), clamp448(b), 0, false); r = __builtin_amdgcn_cvt_pk_fp8_f32(clamp448(c), clamp448(d), r, true); return (unsigned)r; }
__device__ __forceinline__ unsigned pk_h2(float lo, float hi) { h2 v = {(_Float16)lo, (_Float16)hi}; return __builtin_bit_cast(unsigned, v); }
__device__ __forceinline__ float fast_exp(float x) { return __builtin_amdgcn_exp2f(x * 1.44269504089f); }
__device__ __forceinline__ float gelu_tanh(float x) {
    const float u = 1.5957691216f * (x + 0.044715f * x * x * x);
    return x * __builtin_amdgcn_rcpf(1.0f + fast_exp(-u));
}
__device__ __forceinline__ float relu1(float x) { float r; asm("v_max_f32 %0, 0, %1" : "=v"(r) : "v"(x)); return r; }
__device__ __forceinline__ float silu_f(float x) { return x * __builtin_amdgcn_rcpf(1.0f + fast_exp(-x)); }
__device__ __forceinline__ unsigned cvtpk_bf16(float lo, float hi) { unsigned r; asm volatile("v_cvt_pk_bf16_f32 %0, %1, %2" : "=v"(r) : "v"(lo), "v"(hi)); return r; }

namespace pg8 {
constexpr int BM = 256, BK = 64, HALF = 128, HTB = HALF * BK * 2, STAGE_BYTES = 8 * HTB, NXCD = 8, WGM = 8;
__host__ __device__ __forceinline__ int lds_byte(int r, int c) { const int st = (r >> 4) * 2 + (c >> 5), rr = r & 15, cc = c & 31, ob = rr * 64 + cc * 2; return st * 1024 + (ob ^ (((ob >> 9) & 1) << 5)); }
__host__ __device__ __forceinline__ void stage_rc(int b, int& R, int& C) { const int st = b / 1024, sb = b % 1024, swz = sb ^ (((sb >> 9) & 1) << 5); R = (st >> 1) * 16 + swz / 64; C = (st & 1) * 32 + (swz % 64) / 2; }
__host__ __device__ __forceinline__ int perm32(int rho) { const int n = rho >> 4, i = rho & 15; return 8 * (i >> 2) + 4 * n + (i & 3); }
typedef int i32x8 __attribute__((ext_vector_type(8)));
__device__ __forceinline__ i32x8 pg8_cat(h8 lo, h8 hi) { const u32x4 a = __builtin_bit_cast(u32x4, lo), b = __builtin_bit_cast(u32x4, hi); return (i32x8){(int)a.x, (int)a.y, (int)a.z, (int)a.w, (int)b.x, (int)b.y, (int)b.z, (int)b.w}; }
struct Unit { int pm, pn; };
struct Gemm { const void* A; const void* Bt; int M, N, K; };
struct StaticOrder {
    int nM, nN, nwg, G, c, gap_at, gap;
    __host__ __device__ void init(int M, int N, int G_, int c_, int gap_at_ = 0, int gap_ = 0) { nM = M / BM; nN = N / BM; nwg = nM * nN; G = G_; c = c_; gap_at = gap_at_; gap = gap_; }
    __host__ __device__ bool next(int i, Unit& u) const {
        const long L = (long)i * G + c; if (L >= nwg) return false;
        int wgid = (int)L; { const int q = nwg / NXCD, r = nwg % NXCD, xcd = wgid % NXCD, off = wgid / NXCD; wgid = (xcd < r ? xcd * (q + 1) : r * (q + 1) + (xcd - r) * q) + off; }
        const int nig = WGM * nN, gid = wgid / nig, fm = gid * WGM, gsz = (nM - fm) < WGM ? (nM - fm) : WGM;
        u.pm = fm + ((wgid % nig) % gsz); u.pn = (wgid % nig) / gsz; if (u.pn >= gap_at) u.pn += gap; return true;
    }
};

template <class Epi, bool ALIGN_EPI = true, bool SP2 = true, bool FP8 = false>
__device__ __forceinline__ void gemm_phase(LAS unsigned char* lds, const Gemm g, const StaticOrder& S, const Epi& E) {
    int tid_ = threadIdx.x; asm volatile("" : "+v"(tid_));
    const int tid = tid_, wid = __builtin_amdgcn_readfirstlane(tid >> 6), lane = tid & 63, wr = wid >> 2, wc = wid & 3, fr = lane & 15, fq = lane >> 4;
    const int K = g.K, RB = FP8 ? K : 2 * K  , nt = RB / 128;
    unsigned voffA[2], voffB[2];
#pragma unroll
    for (int i = 0; i < 2; ++i) { int R, C; stage_rc(tid * 16 + i * 8192, R, C); const int Rb = Epi::PERM ? ((R & ~31) + perm32(R & 31)) : R;
        voffA[i] = (unsigned)(R * RB + 2 * C); voffB[i] = (unsigned)(Rb * RB + 2 * C); }
    const size_t kstep = (size_t)(BK * 2);
    const size_t hstep = (size_t)HALF * RB;
    const size_t tstep = 2 * hstep;
    const unsigned ldsw = (unsigned)wid * 1024u;
    const int aoff = lds_byte(wr * 64 + fr, fq * 8), boff = lds_byte(wc * 32 + fr, fq * 8);
#define PG8_SA(b, h) (((b) * 2 + (h)) * HTB)
#define PG8_SB(b, h) ((4 + (b) * 2 + (h)) * HTB)
#define PG8_STAGE(bufoff, gbase, voff) do { _Pragma("unroll") for (int _i = 0; _i < 2; ++_i) { unsigned _v = (voff)[_i]; if constexpr (FP8) asm volatile("" : "+v"(_v)); \
        __builtin_amdgcn_global_load_lds((const unsigned*)((const char*)(gbase) + _v), (LAS unsigned*)(lds + (bufoff) + ldsw + _i * 8192), 16, 0, 0); } } while (0)
#define PG8_LDA(dst, b, h) do { _Pragma("unroll") for (int m = 0; m < 4; ++m) _Pragma("unroll") for (int k = 0; k < 2; ++k) dst[m][k] = *(const LAS h8*)(lds + PG8_SA(b, h) + aoff + m * 2048 + k * 1024); } while (0)
#define PG8_LDB(dst, b, h) do { _Pragma("unroll") for (int n = 0; n < 2; ++n) _Pragma("unroll") for (int k = 0; k < 2; ++k) dst[n][k] = *(const LAS h8*)(lds + PG8_SB(b, h) + boff + n * 2048 + k * 1024); } while (0)
#define PG8_MMA(ai, bj, At, Bt) do { __builtin_amdgcn_s_setprio(1); \
        if constexpr (FP8) { _Pragma("unroll") for (int m = 0; m < 4; ++m) _Pragma("unroll") for (int n = 0; n < 2; ++n) \
            acc[ai][bj][m][n] = __builtin_amdgcn_mfma_scale_f32_16x16x128_f8f6f4(pg8_cat(Bt[n][0], Bt[n][1]), pg8_cat(At[m][0], At[m][1]), acc[ai][bj][m][n], 0, 0, 0, 0x7F7F7F7F, 0, 0x7F7F7F7F); } \
        else { _Pragma("unroll") for (int m = 0; m < 4; ++m) _Pragma("unroll") for (int n = 0; n < 2; ++n) _Pragma("unroll") for (int k = 0; k < 2; ++k) \
            acc[ai][bj][m][n] = __builtin_amdgcn_mfma_f32_16x16x32_f16(Bt[n][k], At[m][k], acc[ai][bj][m][n], 0, 0, 0); } \
        __builtin_amdgcn_s_setprio(0); } while (0)
#define PG8_WAIT_V(n) asm volatile("s_waitcnt vmcnt(" #n ")" ::: "memory")
#define PG8_WAIT_L(n) asm volatile("s_waitcnt lgkmcnt(" #n ")" ::: "memory")
#define PG8_BAR __builtin_amdgcn_s_barrier()
#define PG8_SCHED __builtin_amdgcn_sched_barrier(0)
    Unit cur, nxt; int ui = 0;
    if (!S.next(0, cur)) return;
    f32x4 acc[2][2][4][2];
#pragma unroll
    for (int a = 0; a < 2; ++a)
#pragma unroll
        for (int b = 0; b < 2; ++b)
#pragma unroll
            for (int m = 0; m < 4; ++m)
#pragma unroll
                for (int n = 0; n < 2; ++n) acc[a][b][m][n] = (f32x4){0.f, 0.f, 0.f, 0.f};
    h8 At[4][2], B0[2][2], B1[2][2];
    const char* cA = (const char*)g.A + (size_t)cur.pm * tstep; const char* cB = (const char*)g.Bt + (size_t)cur.pn * tstep;
    if constexpr (Epi::HAS_MID) E.begin(cur, ui, lds);
    if constexpr (SP2) {
        PG8_STAGE(PG8_SB(0, 0), cB, voffB); PG8_STAGE(PG8_SB(0, 1), cB + hstep, voffB); PG8_STAGE(PG8_SA(0, 0), cA, voffA); PG8_STAGE(PG8_SA(0, 1), cA + hstep, voffA);
        if (wr == 1) PG8_BAR;
        PG8_WAIT_V(2); PG8_BAR;
        PG8_STAGE(PG8_SB(1, 0), cB + kstep, voffB); PG8_STAGE(PG8_SA(1, 0), cA + kstep, voffA); PG8_STAGE(PG8_SB(1, 1), cB + hstep + kstep, voffB);
        PG8_WAIT_V(6); PG8_BAR;
    } else {
        PG8_STAGE(PG8_SB(0, 0), cB, voffB); PG8_STAGE(PG8_SA(0, 0), cA, voffA); PG8_STAGE(PG8_SB(0, 1), cB + hstep, voffB); PG8_STAGE(PG8_SA(0, 1), cA + hstep, voffA);
        if (wr == 1) PG8_BAR;
        PG8_WAIT_V(4); PG8_BAR;
        PG8_STAGE(PG8_SB(1, 0), cB + kstep, voffB); PG8_STAGE(PG8_SA(1, 0), cA + kstep, voffA); PG8_STAGE(PG8_SB(1, 1), cB + hstep + kstep, voffB);
        PG8_WAIT_V(6); PG8_BAR;
    }
    for (;;) {
        const bool has_next = S.next(ui + 1, nxt);
        const char* nA = has_next ? (const char*)g.A + (size_t)nxt.pm * tstep : cA; const char* nB = has_next ? (const char*)g.Bt + (size_t)nxt.pn * tstep : cB;
        for (int t = 0; t < nt; t += 2) {
            const bool last = (t == nt - 2);
            const char* a1 = cA + (size_t)(t + 1) * kstep;
            const char* a2 = last ? nA : cA + (size_t)(t + 2) * kstep; const char* b2 = last ? nB : cB + (size_t)(t + 2) * kstep;
            const char* a3 = a2 + kstep; const char* b3 = b2 + kstep;
            if constexpr (Epi::HAS_MID) { if (t == nt / 2) { int le_ = threadIdx.x & 15; asm volatile("" : "+v"(le_)); E.mid(acc, ui, wr, le_, lds); } }
            if constexpr (SP2) {
            PG8_LDB(B0, 0, 0); PG8_LDB(B1, 0, 1); PG8_SCHED; PG8_LDA(At, 0, 0); PG8_STAGE(PG8_SA(1, 1), a1 + hstep, voffA);
            PG8_WAIT_V(8); PG8_WAIT_L(0); PG8_BAR; PG8_MMA(0, 0, At, B0); PG8_MMA(0, 1, At, B1); PG8_BAR; PG8_SCHED;
            PG8_LDA(At, 0, 1); PG8_STAGE(PG8_SB(0, 0), b2, voffB); PG8_STAGE(PG8_SB(0, 1), b2 + hstep, voffB); PG8_STAGE(PG8_SA(0, 0), a2, voffA);
            PG8_WAIT_V(8); PG8_WAIT_L(0); PG8_BAR; PG8_MMA(1, 0, At, B0); PG8_MMA(1, 1, At, B1); PG8_BAR; PG8_SCHED;
            PG8_LDB(B0, 1, 0); PG8_LDB(B1, 1, 1); PG8_SCHED; PG8_LDA(At, 1, 0); PG8_STAGE(PG8_SA(0, 1), a2 + hstep, voffA);
            PG8_WAIT_V(8); PG8_WAIT_L(0); PG8_BAR; PG8_MMA(0, 0, At, B0); PG8_MMA(0, 1, At, B1); PG8_BAR; PG8_SCHED;
            PG8_LDA(At, 1, 1); PG8_STAGE(PG8_SB(1, 0), b3, voffB); PG8_STAGE(PG8_SB(1, 1), b3 + hstep, voffB); PG8_STAGE(PG8_SA(1, 0), a3, voffA);
            PG8_WAIT_V(8); PG8_WAIT_L(0); PG8_BAR; PG8_MMA(1, 0, At, B0); PG8_MMA(1, 1, At, B1); PG8_BAR; PG8_SCHED;
            } else {
            PG8_LDB(B0, 0, 0); PG8_SCHED; PG8_LDA(At, 0, 0); PG8_STAGE(PG8_SA(1, 1), a1 + hstep, voffA);
            PG8_WAIT_L(8); PG8_BAR; PG8_WAIT_L(0); PG8_MMA(0, 0, At, B0); PG8_BAR; PG8_SCHED;
            PG8_LDB(B1, 0, 1); PG8_STAGE(PG8_SB(0, 0), b2, voffB);
            PG8_BAR; PG8_WAIT_L(0); PG8_MMA(0, 1, At, B1); PG8_BAR;
            PG8_LDA(At, 0, 1); PG8_STAGE(PG8_SA(0, 0), a2, voffA);
            PG8_BAR; PG8_WAIT_L(0); PG8_MMA(1, 0, At, B0); PG8_BAR; PG8_SCHED;
            PG8_STAGE(PG8_SB(0, 1), b2 + hstep, voffB);
            PG8_WAIT_V(6); PG8_BAR; PG8_MMA(1, 1, At, B1); PG8_BAR;
            PG8_LDB(B0, 1, 0); PG8_SCHED; PG8_LDA(At, 1, 0); PG8_STAGE(PG8_SA(0, 1), a2 + hstep, voffA);
            PG8_WAIT_L(8); PG8_BAR; PG8_WAIT_L(0); PG8_MMA(0, 0, At, B0); PG8_BAR; PG8_SCHED;
            PG8_LDB(B1, 1, 1); PG8_STAGE(PG8_SB(1, 0), b3, voffB);
            PG8_BAR; PG8_WAIT_L(0); PG8_MMA(0, 1, At, B1); PG8_BAR;
            PG8_LDA(At, 1, 1); PG8_STAGE(PG8_SA(1, 0), a3, voffA);
            PG8_BAR; PG8_WAIT_L(0); PG8_MMA(1, 0, At, B0); PG8_BAR; PG8_SCHED;
            PG8_STAGE(PG8_SB(1, 1), b3 + hstep, voffB);
            PG8_WAIT_V(6); PG8_BAR; PG8_MMA(1, 1, At, B1); PG8_BAR;
                    }
        }
        if constexpr (ALIGN_EPI) { if (wr == 0) PG8_BAR; }
        { int le_ = threadIdx.x & 63; asm volatile("" : "+v"(le_));
          E(acc, cur, ui, wr, wc, le_ & 15, le_ >> 4, lds); }
        if constexpr (Epi::HAS_AFTER) E.after_unit(ui);
        if (!has_next) break;
#pragma unroll
        for (int a = 0; a < 2; ++a)
#pragma unroll
            for (int b = 0; b < 2; ++b)
#pragma unroll
                for (int m = 0; m < 4; ++m)
#pragma unroll
                    for (int n = 0; n < 2; ++n) acc[a][b][m][n] = (f32x4){0.f, 0.f, 0.f, 0.f};
        cur = nxt; cA = nA; cB = nB; ++ui;
        if constexpr (Epi::HAS_MID) E.begin(cur, ui, lds);
        if constexpr (ALIGN_EPI) { if (wr == 1) PG8_BAR; }
    }
    PG8_WAIT_V(0);
    if constexpr (!ALIGN_EPI) { if (wr == 0) PG8_BAR; }
    PG8_BAR;
#undef PG8_SA
#undef PG8_SB
#undef PG8_STAGE
#undef PG8_LDA
#undef PG8_LDB
#undef PG8_MMA
#undef PG8_WAIT_V
#undef PG8_WAIT_L
#undef PG8_BAR
#undef PG8_SCHED
}
}

struct EpiZ {
    static constexpr bool PERM = true, HAS_MID = false, HAS_AFTER = true;
    unsigned char* ws; float* WI; f32x2* VSTAT; unsigned* done5;
    float zs; int trig;
    __device__ __forceinline__ void begin(const pg8::Unit&, int, LAS unsigned char*) const {}
    __device__ __forceinline__ void mid(f32x4 (&)[2][2][4][2], int, int, int, LAS unsigned char*) const {}
    __device__ __forceinline__ void after_unit(int ui) const {
        if (ui == trig) {
            asm volatile("s_waitcnt vmcnt(0)" ::: "memory");
            __syncthreads();
            if (threadIdx.x == 0) {
                __builtin_amdgcn_fence(__ATOMIC_RELEASE, "agent");
                asm volatile("s_waitcnt vmcnt(0)" ::: "memory");
                __hip_atomic_fetch_add(done5, 1u, __ATOMIC_RELAXED, __HIP_MEMORY_SCOPE_AGENT);
            }
        }
    }
    __device__ __forceinline__ void operator()(const f32x4 (&acc)[2][2][4][2], const pg8::Unit& u, int, int wr, int wc, int fr, int fq, LAS unsigned char*) const {
        asm volatile("" : "+v"(fr), "+v"(fq));
        const int pn = u.pn;
        const int kind = pn < 16 ? 1 : ((pn < 24 || (pn >= 36 && pn < 44)) ? 2 : 0);
        const bool stats = (pn >= 8 && pn < 16);
        const bool blocked = pn < 24;
        size_t base; int ld, cofs;
        if (pn < 8) { base = WS_U; ld = 0; cofs = pn * 256; }
        else if (pn < 16) { base = WS_V; ld = 0; cofs = (pn - 8) * 256; }
        else if (pn < 24) { base = WS_GA; ld = 0; cofs = (pn - 16) * 256; }
        else if (pn < 32) { base = WS_QB; ld = 2048; cofs = (pn - 24) * 256; }
        else if (pn < 34) { base = WS_KB; ld = 512; cofs = (pn - 32) * 256; }
        else if (pn < 36) { base = WS_VV; ld = 512; cofs = (pn - 34) * 256; }
        else if (pn < 44) { base = WS_GB; ld = 2048; cofs = (pn - 36) * 256; }
        else if (pn < 60) { base = WS_QI; ld = 4096; cofs = (pn - 44) * 256; }
        else { base = WS_KI; ld = 128; cofs = 0; }
        _Float16* dst = (_Float16*)(ws + base);
        const int row0 = u.pm * 256 + wr * 64 + fr, cl = wc * 32 + 8 * fq;
#pragma unroll
        for (int ai = 0; ai < 2; ++ai)
#pragma unroll
            for (int m = 0; m < 4; ++m) {
                const int row = row0 + ai * 128 + m * 16;
                float s1 = 0.f, s2 = 0.f;
#pragma unroll
                for (int bj = 0; bj < 2; ++bj) {
                    float v[8];
#pragma unroll
                    for (int j = 0; j < 4; ++j) { v[j] = acc[ai][bj][m][0][j] * zs; v[4 + j] = acc[ai][bj][m][1][j] * zs; }
                    if (kind == 1) {
#pragma unroll
                        for (int j = 0; j < 8; ++j) v[j] = gelu_tanh(v[j]);
                    } else if (kind == 2) {
#pragma unroll
                        for (int j = 0; j < 8; ++j) v[j] = silu_f(v[j]);
                    }
                    if (stats) {
#pragma unroll
                        for (int j = 0; j < 8; ++j) { s1 += v[j]; s2 += v[j] * v[j]; }
                    }
                    u32x4 w;
                    if (pn == 34 || pn == 35) { w.x = cvtpk_bf16(v[0], v[1]); w.y = cvtpk_bf16(v[2], v[3]); w.z = cvtpk_bf16(v[4], v[5]); w.w = cvtpk_bf16(v[6], v[7]); }
                    else { w.x = pk_h2(v[0], v[1]); w.y = pk_h2(v[2], v[3]); w.z = pk_h2(v[4], v[5]); w.w = pk_h2(v[6], v[7]); }
                    if (blocked) {
                        const int head = (cofs >> 7) + bj;
                        *(u32x4*)(dst + ((size_t)((row >> 7) * 16 + head) * 128 + (row & 127)) * 128 + cl) = w;
                    } else if (pn < 60) {
                        *(u32x4*)(dst + (size_t)row * ld + cofs + bj * 128 + cl) = w;
                    } else if (bj == 0) {
                        *(u32x4*)(dst + (size_t)row * 128 + cl) = w;
                    } else if (wc == 0) {
                        float* wp = WI + (size_t)row * 32 + 8 * fq;
                        *(f32x4*)wp = (f32x4){v[0], v[1], v[2], v[3]} * 0.015625f;
                        *(f32x4*)(wp + 4) = (f32x4){v[4], v[5], v[6], v[7]} * 0.015625f;
                    }
                }
                if (stats) {
                    s1 = xsum32(xsum16(s1)); s2 = xsum32(xsum16(s2));
                    if (fq == 0) VSTAT[(size_t)row * 32 + (pn - 8) * 4 + wc] = (f32x2){s1, s2};
                }
            }
    }
};

struct EpiOut {
    static constexpr bool PERM = false, HAS_MID = true, HAS_AFTER = false;
    const float* x; float* out; const float* mod; const float* ssqa; const float* ssqb;
    __device__ __forceinline__ void begin(const pg8::Unit& u, int ui, LAS unsigned char* lds) const {
        int tid = threadIdx.x; asm volatile("" : "+v"(tid));
        if (tid < 256) {
            const int row = u.pm * 256 + tid;
            const f32x4* pa = (const f32x4*)(ssqa + (size_t)row * 16);
            f32x4 a0 = pa[0], a1 = pa[1], a2 = pa[2], a3 = pa[3];
            const f32x4* pb = (const f32x4*)(ssqb + (size_t)row * 16);
            f32x4 b0 = pb[0], b1 = pb[1], b2 = pb[2], b3 = pb[3];
            b0 = (b0 + b1) + (b2 + b3);
            a0 = (a0 + a1) + (a2 + a3);
            const float sa = (a0[0] + a0[1]) + (a0[2] + a0[3]), sb = (b0[0] + b0[1]) + (b0[2] + b0[3]);
            const float ra = 1.0f / sqrtf(sa * (1.0f / 2048.0f) + EPS), rb = 1.0f / sqrtf(sb * (1.0f / 2048.0f) + EPS);
            LAS f32x2* F = (LAS f32x2*)(lds + LDS_X) + (ui & 1) * 256;
            F[tid] = (f32x2){(ra * Y8_SB) / (rb * Y8_SA), rb * (1.0f / (Y8_SB * W8_S))};
        }
    }
    __device__ __forceinline__ void mid(f32x4 (&acc)[2][2][4][2], int ui, int wr, int fr, LAS unsigned char* lds) const {
        asm volatile("" : "+v"(fr));
        const LAS f32x2* F = (const LAS f32x2*)(lds + LDS_X) + (ui & 1) * 256;
#pragma unroll
        for (int ai = 0; ai < 2; ++ai)
#pragma unroll
            for (int m = 0; m < 4; ++m) {
                const float r = F[ai * 128 + wr * 64 + m * 16 + fr].x;
#pragma unroll
                for (int bj = 0; bj < 2; ++bj)
#pragma unroll
                    for (int n = 0; n < 2; ++n) acc[ai][bj][m][n] = acc[ai][bj][m][n] * r;
            }
    }
    __device__ __forceinline__ void operator()(const f32x4 (&acc)[2][2][4][2], const pg8::Unit& u, int ui, int wr, int wc, int fr, int fq, LAS unsigned char* lds) const {
        asm volatile("" : "+v"(fr), "+v"(fq));
        const LAS f32x2* F = (const LAS f32x2*)(lds + LDS_X) + (ui & 1) * 256;
        const int b = u.pm >> 3;
        const int col0 = u.pn * 256 + wc * 32 + 4 * fq;
        f32x4 gv[2][2];
#pragma unroll
        for (int bj = 0; bj < 2; ++bj)
#pragma unroll
            for (int n = 0; n < 2; ++n) gv[bj][n] = *(const f32x4*)(mod + (size_t)b * 3 * DM + 2 * DM + col0 + bj * 128 + n * 16);
        f32x4 xa[2][2], xb[2][2];
#define EPO_LOAD(dst, g_) do { const int rl_ = ((g_) >> 2) * 128 + wr * 64 + ((g_) & 3) * 16 + fr; const size_t off_ = (size_t)(u.pm * 256 + rl_) * DM + col0; \
        _Pragma("unroll") for (int bj = 0; bj < 2; ++bj) _Pragma("unroll") for (int n = 0; n < 2; ++n) dst[bj][n] = *(const f32x4*)(x + off_ + bj * 128 + n * 16); } while (0)
#define EPO_STORE(src, g_) do { const int rl_ = ((g_) >> 2) * 128 + wr * 64 + ((g_) & 3) * 16 + fr; const size_t off_ = (size_t)(u.pm * 256 + rl_) * DM + col0; const float rb_ = F[rl_].y; \
        _Pragma("unroll") for (int bj = 0; bj < 2; ++bj) _Pragma("unroll") for (int n = 0; n < 2; ++n) \
            __builtin_nontemporal_store(src[bj][n] + gv[bj][n] * (acc[(g_) >> 2][bj][(g_) & 3][n] * rb_), (f32x4*)(out + off_ + bj * 128 + n * 16)); } while (0)
        EPO_LOAD(xa, 0);
        EPO_LOAD(xb, 1); EPO_STORE(xa, 0); asm volatile("" ::: "memory");
        EPO_LOAD(xa, 2); EPO_STORE(xb, 1); asm volatile("" ::: "memory");
        EPO_LOAD(xb, 3); EPO_STORE(xa, 2); asm volatile("" ::: "memory");
        EPO_LOAD(xa, 4); EPO_STORE(xb, 3); asm volatile("" ::: "memory");
        EPO_LOAD(xb, 5); EPO_STORE(xa, 4); asm volatile("" ::: "memory");
        EPO_LOAD(xa, 6); EPO_STORE(xb, 5); asm volatile("" ::: "memory");
        EPO_LOAD(xb, 7); EPO_STORE(xa, 6); asm volatile("" ::: "memory");
        EPO_STORE(xb, 7);
#undef EPO_LOAD
#undef EPO_STORE
    }
};


namespace att {
typedef short bf16x8 __attribute__((ext_vector_type(8)));
typedef short s16x4 __attribute__((ext_vector_type(4)));
#define ATT_KSWZ(row, colB) ((row) * 256 + ((colB) ^ (((row) & 7) << 4)))
#define ATT_SBAR() __builtin_amdgcn_sched_barrier(0)
__device__ __forceinline__ int crow(int r, int hi) { return (r & 3) + 8 * (r >> 2) + 4 * hi; }
__device__ __forceinline__ int v_st(int k, int c) { const int kk = (k & ~0xC) | ((k & 4) << 1) | ((k & 8) >> 1); return ((kk >> 3) * 4 + (c >> 5)) * 512 + ((kk & 7) * 32 + (c & 31)) * 2; }
__device__ __forceinline__ int v_rd_base(int lane) { return ((lane & 3) << 3) | (((lane >> 2) & 3) << 6) | (((lane >> 4) & 1) << 5) | (((lane >> 5) & 1) << 8); }
constexpr int v_rd_off(int d0, int ks, int half) { return d0 * 512 + ks * 4096 + half * 2048; }
template <int OFF> __device__ __forceinline__ s16x4 tr_read(int vb) {
    s16x4 r; asm volatile("ds_read_b64_tr_b16 %0, %1 offset:%2" : "=&v"(r) : "v"(vb), "i"(OFF) : "memory"); return r;
}
template <int D0> __device__ __forceinline__ void pv_one(f32x16& od, int vb, bf16x8 pa0, bf16x8 pa1, bf16x8 pa2, bf16x8 pa3) {
    const s16x4 l0 = tr_read<v_rd_off(D0, 0, 0)>(vb), h0 = tr_read<v_rd_off(D0, 0, 1)>(vb), l1 = tr_read<v_rd_off(D0, 1, 0)>(vb), h1 = tr_read<v_rd_off(D0, 1, 1)>(vb);
    const s16x4 l2 = tr_read<v_rd_off(D0, 2, 0)>(vb), h2 = tr_read<v_rd_off(D0, 2, 1)>(vb), l3 = tr_read<v_rd_off(D0, 3, 0)>(vb), h3 = tr_read<v_rd_off(D0, 3, 1)>(vb);
    asm volatile("s_waitcnt lgkmcnt(0)" ::: "memory"); ATT_SBAR();
#define ATT_PK(L, H) (bf16x8){L[0], L[1], L[2], L[3], H[0], H[1], H[2], H[3]}
    od = __builtin_amdgcn_mfma_f32_32x32x16_bf16(pa0, ATT_PK(l0, h0), od, 0, 0, 0);
    od = __builtin_amdgcn_mfma_f32_32x32x16_bf16(pa1, ATT_PK(l1, h1), od, 0, 0, 0);
    od = __builtin_amdgcn_mfma_f32_32x32x16_bf16(pa2, ATT_PK(l2, h2), od, 0, 0, 0);
    od = __builtin_amdgcn_mfma_f32_32x32x16_bf16(pa3, ATT_PK(l3, h3), od, 0, 0, 0);
#undef ATT_PK
}
__device__ __forceinline__ void qkt(f32x16& p0, f32x16& p1, const LAS unsigned char* Ks, const h8* qr, int r32, int hi) {
#pragma unroll
    for (int r = 0; r < 16; ++r) { p0[r] = 0.f; p1[r] = 0.f; }
#pragma unroll
    for (int d0 = 0; d0 < 8; ++d0) { const int cb = (d0 * 16 + hi * 8) * 2;
        const h8 b0 = *(const LAS h8*)(Ks + ATT_KSWZ(r32, cb));
        const h8 b1 = *(const LAS h8*)(Ks + ATT_KSWZ(32 + r32, cb));
        p0 = __builtin_amdgcn_mfma_f32_32x32x16_f16(b0, qr[d0], p0, 0, 0, 0);
        p1 = __builtin_amdgcn_mfma_f32_32x32x16_f16(b1, qr[d0], p1, 0, 0, 0); }
}
constexpr int L_V = 0, L_K = 32768, L_MSK = 65536, L_LI = L_MSK + 64 * 66 * 4, L_DT = L_LI + 1024, L_BK = L_DT + 4096, L_GQK = L_BK + 512, L_RB = L_GQK + 512, L_END = L_RB + 2048;
}


#define XB_TMO      128
#define XB_XCNT(j)  (256  + 64 * (j))
#define XB_XSUB(j)  (1280 + 64 * (j))
#define XB_XGEN(j)  (2304 + 64 * (j))
#define XB_TOP      3328
#define XB_TOPGEN   3392
#define XCD_BAR_WORDS 3456
#define XB_SPIN_CAP (1u << 18)
__device__ __forceinline__ unsigned xb_ld(unsigned* p)              { return __hip_atomic_load(p, __ATOMIC_RELAXED, __HIP_MEMORY_SCOPE_AGENT); }
__device__ __forceinline__ unsigned xb_add(unsigned* p, unsigned v) { return __hip_atomic_fetch_add(p, v, __ATOMIC_RELAXED, __HIP_MEMORY_SCOPE_AGENT); }
__device__ __forceinline__ unsigned xb_xcc_id() { return (unsigned)__builtin_amdgcn_s_getreg((3 << 11) | 20) & 0xFu; }
#define XB_SPIN(cond, bar) do { unsigned _sp = 0; while (cond) { __builtin_amdgcn_s_sleep(1); \
    if ((++_sp & 255u) == 0u) { if (xb_ld(&(bar)[XB_TMO])) break; if (_sp > XB_SPIN_CAP) { atomicAdd(&(bar)[XB_TMO], 1u); break; } } } } while (0)
struct XcdBarrier { unsigned* bar; unsigned x; volatile LAS unsigned* st; };
__device__ __forceinline__ XcdBarrier xcd_barrier_post(unsigned* bar, volatile LAS unsigned* st) {
    XcdBarrier b; b.bar = bar; b.x = xb_xcc_id(); b.st = st;
    if (threadIdx.x == 0) (void)xb_add(&bar[XB_XCNT(b.x)], 1u);
    return b;
}
__device__ __forceinline__ void xcd_barrier_complete(unsigned* bar, unsigned x, unsigned& nloc, unsigned& nx) {
    const unsigned G = gridDim.x * gridDim.y * gridDim.z;
    unsigned sum, cnt, mine, sp = 0u;
    for (;;) {
        sum = 0u; cnt = 0u; mine = 0u;
#pragma unroll
        for (unsigned j = 0; j < 16; ++j) { const unsigned c = xb_ld(&bar[XB_XCNT(j)]); sum += c; cnt += (c > 0u) ? 1u : 0u; mine = (j == x) ? c : mine; }
        if (sum == G) break;
        __builtin_amdgcn_s_sleep(1);
        if ((++sp & 255u) == 0u) { if (xb_ld(&bar[XB_TMO])) break; if (sp > XB_SPIN_CAP) { atomicAdd(&bar[XB_TMO], 1u); break; } }
    }
    nloc = mine > 0u ? mine : 1u; nx = cnt > 0u ? cnt : 1u;
}
__device__ __forceinline__ void xcd_barrier(const XcdBarrier& b) {
    asm volatile("s_waitcnt vmcnt(0)" ::: "memory");
    __syncthreads();
    if (threadIdx.x == 0) {
        unsigned* bar = b.bar;
        __builtin_amdgcn_s_waitcnt(0);
        unsigned nloc = b.st[0], nx = b.st[1];
        if (nloc == 0u) { xcd_barrier_complete(bar, b.x, nloc, nx); b.st[0] = nloc; b.st[1] = nx; }
        const unsigned old = xb_add(&bar[XB_XSUB(b.x)], 1u);
        const unsigned gen = old / nloc;
        if (old + 1u == (gen + 1u) * nloc) {
            __builtin_amdgcn_fence(__ATOMIC_RELEASE, "agent");
            asm volatile("s_waitcnt vmcnt(0)" ::: "memory");
            const unsigned og = xb_add(&bar[XB_TOP], 1u);
            const unsigned tg = og / nx;
            if (og + 1u == (tg + 1u) * nx) xb_add(&bar[XB_TOPGEN], 1u);
            else XB_SPIN(xb_ld(&bar[XB_TOPGEN]) == tg, bar);
            __builtin_amdgcn_fence(__ATOMIC_ACQUIRE, "agent");
            xb_add(&bar[XB_XGEN(b.x)], 1u);
            asm volatile("s_waitcnt vmcnt(0)" ::: "memory");
        } else {
            XB_SPIN(xb_ld(&bar[XB_XGEN(b.x)]) == gen, bar);
            __builtin_amdgcn_fence(__ATOMIC_ACQUIRE, "agent");
            asm volatile("s_waitcnt vmcnt(0)" ::: "memory");
        }
    }
    __syncthreads();
}

__device__ __forceinline__ unsigned tk_key(unsigned bits) { return (bits & 0x80000000u) ? ~bits : (bits | 0x80000000u); }
__device__ __forceinline__ float tk_val(unsigned k) { return __uint_as_float((k & 0x80000000u) ? (k & 0x7FFFFFFFu) : ~k); }
__device__ __forceinline__ void topk_select(unsigned (&uk)[32], int t, unsigned* mrow, int lane, LAS unsigned* cb) {
    unsigned wlo = 0u, whi = 0u;
#define TK_PUT(i_, m_) do { asm volatile("s_nop 4\n\tv_writelane_b32 %0, %2, %4\n\tv_writelane_b32 %1, %3, %4" : "+v"(wlo), "+v"(whi) : "s"((unsigned)(m_)), "s"((unsigned)((m_) >> 32)), "n"(i_)); } while (0)
    if (t + 1 <= TOPK) {
#pragma unroll
        for (int i = 0; i < 32; ++i) { const unsigned long long m = __ballot(64 * i + lane <= t); TK_PUT(i, m); }
        if (lane < 32) *(u32x2*)(mrow + 2 * lane) = (u32x2){wlo, whi};
        return;
    }
#define TK_COUNT(cand_, cnt_) do { int c0_ = 0, c1_ = 0; \
        _Pragma("unroll") for (int i = 0; i < 32; i += 2) { c0_ += (uk[i] >= (cand_)) ? 1 : 0; c1_ += (uk[i + 1] >= (cand_)) ? 1 : 0; } \
        int c_ = c0_ + c1_; \
        c_ += __builtin_amdgcn_update_dpp(0, c_, 0xB1, 0xF, 0xF, false); c_ += __builtin_amdgcn_update_dpp(0, c_, 0x4E, 0xF, 0xF, false); \
        c_ += __builtin_amdgcn_update_dpp(0, c_, 0x141, 0xF, 0xF, false); c_ += __builtin_amdgcn_update_dpp(0, c_, 0x140, 0xF, 0xF, false); \
        cnt_ = __builtin_amdgcn_readlane(c_, 0) + __builtin_amdgcn_readlane(c_, 16) + __builtin_amdgcn_readlane(c_, 32) + __builtin_amdgcn_readlane(c_, 48); } while (0)
    unsigned M = 0u, mn = 0xFFFFFFFFu;
#pragma unroll
    for (int i = 0; i < 32; ++i) { M = uk[i] > M ? uk[i] : M; const unsigned k1 = uk[i] - 1u; mn = k1 < mn ? k1 : mn; }
#pragma unroll
    for (int o = 1; o < 64; o <<= 1) { const unsigned v = (unsigned)__shfl_xor((int)M, o); M = v > M ? v : M; const unsigned w = (unsigned)__shfl_xor((int)mn, o); mn = w < mn ? w : mn; }
    M = (unsigned)__builtin_amdgcn_readfirstlane((int)M); mn = (unsigned)__builtin_amdgcn_readfirstlane((int)mn);
    unsigned lok = mn + 1u, hik = M + 1u;
    float lof = tk_val(lok), hif = tk_val(M);
    int cnt_lo = t + 1, cnt_hi = 0; bool exact = false;
#pragma unroll 1
    while (!exact && cnt_lo - cnt_hi > 64 && hik - lok > 1u) {
        float cf = 0.5f * lof + 0.5f * hif;
        unsigned ck = tk_key(__float_as_uint(cf));
        if (!(ck > lok && ck < hik)) { ck = lok + ((hik - lok) >> 1); cf = tk_val(ck); }
        ck = (unsigned)__builtin_amdgcn_readfirstlane((int)ck);
        int cnt; TK_COUNT(ck, cnt);
        if (cnt >= TOPK) { lok = ck; lof = cf; cnt_lo = cnt; } else { hik = ck; hif = cf; cnt_hi = cnt; }
        if (cnt == TOPK) exact = true;
    }
#undef TK_COUNT
    unsigned T = lok;
    if (!exact && cnt_lo - cnt_hi <= 64) {
        const unsigned span = hik - lok;
        int base = 0;
#pragma unroll
        for (int i = 0; i < 32; ++i) {
            const bool al = (uk[i] - lok) < span;
            const unsigned long long m = __ballot(al);
            if (m) {
                if (al) cb[base + (int)__builtin_amdgcn_mbcnt_hi((unsigned)(m >> 32), __builtin_amdgcn_mbcnt_lo((unsigned)m, 0u))] = uk[i];
                base += __popcll(m);
            }
        }
        asm volatile("s_waitcnt lgkmcnt(0)" ::: "memory");
        const unsigned key = (lane < base) ? cb[lane] : 0u;
        const int r = TOPK - cnt_hi;
        unsigned lo2 = lok, hi2 = hik;
#pragma unroll 1
        while (hi2 - lo2 > 1u) {
            const unsigned mid = lo2 + ((hi2 - lo2) >> 1);
            if (__popcll(__ballot(key >= mid)) >= r) lo2 = mid; else hi2 = mid;
        }
        T = lo2;
        exact = (cnt_hi + __popcll(__ballot(key >= T)) == TOPK);
    }
    asm volatile("" : "+v"(T));
    if (exact) {
#pragma unroll
        for (int i = 0; i < 32; ++i) { const unsigned long long m = __ballot(uk[i] >= T); TK_PUT(i, m); }
    } else {
        int cgt = 0;
#pragma unroll
        for (int i = 0; i < 32; ++i) cgt += __popcll(__ballot(uk[i] > T));
        int need = TOPK - cgt;
#pragma unroll 1
        for (int i = 0; i < 32; ++i) {
            unsigned ui = 0u;
#pragma unroll
            for (int q = 0; q < 32; ++q) ui = (q == i) ? uk[q] : ui;
            const unsigned long long gt = __ballot(ui > T);
            unsigned long long eq = __ballot(ui == T);
            int ce = __popcll(eq);
            while (ce > need) { eq &= ~(1ull << (63 - __clzll(eq))); --ce; }
            need -= ce;
            const unsigned long long m = gt | eq;
            wlo = (lane == i) ? (unsigned)m : wlo; whi = (lane == i) ? (unsigned)(m >> 32) : whi;
        }
    }
    if (lane < 32) *(u32x2*)(mrow + 2 * lane) = (u32x2){wlo, whi};
#undef TK_PUT
}

struct GmlpPar { const float* ln_v_g; const float* ln_v_b; const float* b_s; const float* out_norm_a_g; };
__device__ __forceinline__ void gmlp_unit(int un, const _Float16* UBl, const _Float16* VBl, const _Float16* GABl, const _Float16* WS16, const f32x2* VSTAT, unsigned char* Y, float* SSQA,
                                          const GmlpPar a, LAS unsigned char* lds, int tid, int lane, int wave) {
    LAS _Float16* vnT = (LAS _Float16*)lds;
    LAS float* sp = (LAS float*)(lds + 34816);
    LAS float* mu = (LAS float*)(lds + 34816 + 67584);
    const int r32 = lane & 31, hi = lane >> 5, tb = wave >> 1, chalf = wave & 1;
    const int hh = un & 15, nchk = (un >> 4) & 15, b = un >> 8;
    const int tok0 = b * SEQ + nchk * 128, c0 = hh * 128;
    const size_t tile = (size_t)((b * 16 + nchk) * 16 + hh) * 16384;
    const int tq = tid >> 5, cq = tid & 31;
    const int stt = tid >> 2, spart = tid & 3;
    f32x2 stv[8];
    { const f32x2* vp = VSTAT + (size_t)(tok0 + stt) * 32 + spart * 8;
#pragma unroll
      for (int q = 0; q < 8; ++q) stv[q] = vp[q]; }
    const int vcc = ((tid >> 4) & 15) * 8, vtk = (tid >> 8) * 16 + (tid & 15);
    h8 gvv[4];
#pragma unroll
    for (int p = 0; p < 4; ++p) gvv[p] = *(const h8*)(VBl + tile + (vtk + 32 * p) * 128 + vcc);
    const f32x4 lg0 = *(const f32x4*)(a.ln_v_g + c0 + vcc), lg1 = *(const f32x4*)(a.ln_v_g + c0 + vcc + 4);
    const f32x4 lb0 = *(const f32x4*)(a.ln_v_b + c0 + vcc), lb1 = *(const f32x4*)(a.ln_v_b + c0 + vcc + 4);
    h8 wfr[8];
    { const _Float16* wp = WS16 + ((size_t)hh * 128 + 32 * tb + r32) * 128 + 8 * hi;
#pragma unroll
      for (int kk = 0; kk < 8; ++kk) wfr[kk] = (kk <= 2 * tb + 1) ? *(const h8*)(wp + 16 * kk) : (h8){0, 0, 0, 0, 0, 0, 0, 0}; }
    h4 gu[8], gg[8]; float bsv[8];
#pragma unroll
    for (int i = 0; i < 8; ++i) { const int tt = tq * 8 + i; gu[i] = __builtin_nontemporal_load((const h4*)(UBl + tile + tt * 128 + 4 * cq)); gg[i] = __builtin_nontemporal_load((const h4*)(GABl + tile + tt * 128 + 4 * cq)); bsv[i] = a.b_s[hh * 128 + tt]; }
    const f32x4 og = *(const f32x4*)(a.out_norm_a_g + c0 + 4 * cq);
    __syncthreads();
    {
        float s1 = 0.f, s2 = 0.f;
#pragma unroll
        for (int q = 0; q < 8; ++q) { s1 += stv[q].x; s2 += stv[q].y; }
        s1 = sum4(s1); s2 = sum4(s2);
        const float mean = s1 * (1.0f / 2048.0f), var = fmaxf(s2 * (1.0f / 2048.0f) - mean * mean, 0.f);
        if (spart == 0) { mu[stt] = mean; mu[128 + stt] = 1.0f / sqrtf(var + EPS); }
    }
    __syncthreads();
#pragma unroll
    for (int p = 0; p < 4; ++p) {
        const int s_ = vtk + 32 * p;
        const float m_ = mu[s_], r_ = mu[128 + s_];
#pragma unroll
        for (int q = 0; q < 4; ++q) {
            vnT[(vcc + q) * 136 + s_] = (_Float16)(((float)gvv[p][q] - m_) * r_ * lg0[q] + lb0[q]);
            vnT[(vcc + 4 + q) * 136 + s_] = (_Float16)(((float)gvv[p][4 + q] - m_) * r_ * lg1[q] + lb1[q]);
        }
    }
    __syncthreads();
    {
        f32x16 acc0, acc1;
#pragma unroll
        for (int r = 0; r < 16; ++r) { acc0[r] = 0.f; acc1[r] = 0.f; }
        const LAS _Float16* bp = vnT + (chalf * 64 + r32) * 136 + 8 * hi;
#pragma unroll
        for (int kk = 0; kk < 8; ++kk) {
            if (kk <= 2 * tb + 1) {
                const h8 b0 = *(const LAS h8*)(bp + 16 * kk), b1 = *(const LAS h8*)(bp + 32 * 136 + 16 * kk);
                acc0 = __builtin_amdgcn_mfma_f32_32x32x16_f16(wfr[kk], b0, acc0, 0, 0, 0);
                acc1 = __builtin_amdgcn_mfma_f32_32x32x16_f16(wfr[kk], b1, acc1, 0, 0, 0);
            }
        }
#pragma unroll
        for (int r = 0; r < 16; ++r) {
            const int tt = 32 * tb + (r & 3) + 8 * (r >> 2) + 4 * hi;
            sp[tt * 132 + chalf * 64 + r32] = acc0[r]; sp[tt * 132 + chalf * 64 + 32 + r32] = acc1[r];
        }
    }
    __syncthreads();
#pragma unroll
    for (int i = 0; i < 8; ++i) {
        const int tt = tq * 8 + i; const size_t row = (size_t)(tok0 + tt);
        const f32x4 spv = *(const LAS f32x4*)(sp + tt * 132 + 4 * cq);
        f32x4 y; float ss = 0.f;
#pragma unroll
        for (int q = 0; q < 4; ++q) { y[q] = (float)gu[i][q] * (spv[q] + bsv[i]); ss += y[q] * y[q]; y[q] = y[q] * og[q] * (float)gg[i][q]; }
        ss = sum32(ss);
        if (cq == 0) SSQA[row * 16 + hh] = ss;
        *(unsigned*)(Y + row * DM + c0 + 4 * cq) = pk_fp8x4(y[0] * Y8_SA, y[1] * Y8_SA, y[2] * Y8_SA, y[3] * Y8_SA);
    }
}

struct Args {
    const float* x; const float* c; const float* w_ada; const float* b_ada; const float* norm_g; const float* w_in; const float* ln_v_g; const float* ln_v_b;
    const float* w_s; const float* b_s; const float* q_norm_g; const float* k_norm_g; const float* rel_bias; const float* out_norm_a_g; const float* out_norm_b_g; const float* w_out;
    float* out; unsigned char* ws; int ph_lo, ph_hi;
};

__device__ __forceinline__ void p0_transpose_item(const float* W, int K, int N, _Float16* WT, LAS float* scr, int kb, int nb, int lane) {
    const int k0 = 64 * kb, n0 = 32 * nb;
    const int c = lane & 7;
    if (n0 >= N) {
#pragma unroll
        for (int j = 0; j < 4; ++j) { const int n = (lane >> 3) + 8 * j; *(u32x4*)(WT + (size_t)(n0 + n) * K + k0 + 8 * c) = (u32x4){0u, 0u, 0u, 0u}; }
        return;
    }
#pragma unroll 8
    for (int i = 0; i < 32; ++i) { const int kk = 2 * i + (lane >> 5); scr[kk * 33 + (lane & 31)] = __builtin_nontemporal_load(W + (size_t)(k0 + kk) * N + n0 + (lane & 31)); }
    asm volatile("s_waitcnt lgkmcnt(0)" ::: "memory");
#pragma unroll
    for (int j = 0; j < 4; ++j) { const int n = (lane >> 3) + 8 * j; const LAS float* s = scr + (8 * c) * 33 + n;
        u32x4 o; o.x = pk_h2(s[0 * 33], s[1 * 33]); o.y = pk_h2(s[2 * 33], s[3 * 33]); o.z = pk_h2(s[4 * 33], s[5 * 33]); o.w = pk_h2(s[6 * 33], s[7 * 33]);
        *(u32x4*)(WT + (size_t)(n0 + n) * K + k0 + 8 * c) = o; }
    asm volatile("s_waitcnt lgkmcnt(0)" ::: "memory");
}
__device__ __forceinline__ void p0_transpose_item_f8(const float* W, int K, int N, unsigned char* WT, LAS float* scr, int kb, int nb, int lane) {
    const int k0 = 64 * kb, n0 = 32 * nb;
    const int c = lane & 7;
#pragma unroll 8
    for (int i = 0; i < 32; ++i) { const int kk = 2 * i + (lane >> 5); scr[kk * 33 + (lane & 31)] = __builtin_nontemporal_load(W + (size_t)(k0 + kk) * N + n0 + (lane & 31)); }
    asm volatile("s_waitcnt lgkmcnt(0)" ::: "memory");
#pragma unroll
    for (int j = 0; j < 4; ++j) { const int n = (lane >> 3) + 8 * j; const LAS float* s = scr + (8 * c) * 33 + n;
        u32x2 o; o.x = pk_fp8x4(s[0 * 33] * W8_S, s[1 * 33] * W8_S, s[2 * 33] * W8_S, s[3 * 33] * W8_S); o.y = pk_fp8x4(s[4 * 33] * W8_S, s[5 * 33] * W8_S, s[6 * 33] * W8_S, s[7 * 33] * W8_S);
        *(u32x2*)(WT + (size_t)(n0 + n) * K + k0 + 8 * c) = o; }
    asm volatile("s_waitcnt lgkmcnt(0)" ::: "memory");
}

__global__ void __launch_bounds__(512, 2) fwd_kernel(Args a) {
    extern __shared__ __attribute__((aligned(16))) unsigned char lds_raw[];
    LAS unsigned char* lds = (LAS unsigned char*)lds_raw;
    cg::grid_group grid = cg::this_grid();
    const int tid = threadIdx.x, lane = tid & 63, wave = __builtin_amdgcn_readfirstlane(tid >> 6);
    const int G = gridDim.x, blk = blockIdx.x;
    const int gw = blk * 8 + wave, NGW = G * 8;
    unsigned char* ws = a.ws;
    _Float16* WTin = (_Float16*)(ws + WS_WTIN); unsigned char* WTout = ws + WS_WTOUT;
    _Float16* H = (_Float16*)(ws + WS_H); unsigned char* Y = ws + WS_Y;
    const _Float16* UBl = (const _Float16*)(ws + WS_U); const _Float16* VBl = (const _Float16*)(ws + WS_V); const _Float16* GABl = (const _Float16*)(ws + WS_GA);
    const _Float16* QBm = (const _Float16*)(ws + WS_QB); const _Float16* KBm = (const _Float16*)(ws + WS_KB); const _Float16* VVm = (const _Float16*)(ws + WS_VV);
    const _Float16* GBm = (const _Float16*)(ws + WS_GB); const _Float16* QIm = (const _Float16*)(ws + WS_QI); const _Float16* KIm = (const _Float16*)(ws + WS_KI);
    float* WI = (float*)(ws + WS_WI); float* MODP = (float*)(ws + WS_MODP); float* MOD = (float*)(ws + WS_MOD);
    f32x2* VSTAT = (f32x2*)(ws + WS_VSTAT); unsigned* MASK = (unsigned*)(ws + WS_MASK);
    float* SSQA = (float*)(ws + WS_SSQA); float* SSQB = (float*)(ws + WS_SSQB);
    const int lo = a.ph_lo, hi = a.ph_hi;
    const int gmlp_pre = (G == 256) ? 96 * GM_UPI : 0;
#ifndef PHMASK
#define PHMASK 63
#endif
#define IN(k) (((PHMASK >> (k)) & 1) && lo <= (k) && (k) < hi)
    volatile LAS unsigned* xbw = (volatile LAS unsigned*)(lds + LDS_X + 8192);
    if (tid < 4) xbw[tid] = 0u;
    __syncthreads();
    const XcdBarrier xbar = xcd_barrier_post((unsigned*)ws, xbw);
    if (a.ph_lo < 0) grid.sync();
#define SEAM(k) do { if (IN(k) && IN((k) + 1)) xcd_barrier(xbar); } while (0)

    if (IN(0)) {
        LAS float* sc = (LAS float*)lds;
        for (int i = tid; i < NB * DM; i += 512) sc[i] = silu_f(a.c[i]);
        __syncthreads();
        LAS float* scr = (LAS float*)(lds + 65536 + wave * 8704);
        constexpr int N_ADA = 96 * KSPLIT;
        constexpr int N_TIN = 64 * (NZP / 32), N_TOUT = 64 * (DM / 32), N_WS = 16 * 128;
        for (int it = gw; it < N_ADA + N_TIN + N_TOUT + N_WS; it += NGW) {
            if (it < N_ADA) {
                const int jb = it % 96, ks = it / 96, j0 = jb * 128 + 2 * lane, k0 = ks * (DM / KSPLIT);
                f32x2 acc[NB];
#pragma unroll
                for (int b = 0; b < NB; ++b) acc[b] = (f32x2){0.f, 0.f};
                const float* wp = a.w_ada + (size_t)k0 * (3 * DM) + j0;
#pragma unroll 8
                for (int k = 0; k < DM / KSPLIT; ++k) {
                    const f32x2 w = __builtin_nontemporal_load((const f32x2*)(wp + (size_t)k * (3 * DM)));
#pragma unroll
                    for (int b = 0; b < NB; ++b) acc[b] += w * sc[b * DM + k0 + k];
                }
#pragma unroll
                for (int b = 0; b < NB; ++b) *(f32x2*)(MODP + ((size_t)ks * NB + b) * (3 * DM) + j0) = acc[b];
            } else if (it < N_ADA + N_TIN) {
                const int r = it - N_ADA, kb_ = r / (NZP / 32), nb_ = r % (NZP / 32);
                if (nb_ >= F8LO * 8 && nb_ < F8HI * 8) p0_transpose_item_f8(a.w_in + F8LO * 256, DM, NZ, ws + WS_W8IN, scr, kb_, nb_ - F8LO * 8, lane);
                else p0_transpose_item(a.w_in, DM, NZ, WTin, scr, kb_, nb_, lane);
            } else if (it < N_ADA + N_TIN + N_TOUT) {
                const int r = it - N_ADA - N_TIN; p0_transpose_item_f8(a.w_out, DM, DM, WTout, scr, r / (DM / 32), r % (DM / 32), lane);
            } else {
                const int r = it - N_ADA - N_TIN - N_TOUT, tt = r & 127;
                const f32x2 w = *(const f32x2*)(a.w_s + (size_t)r * 128 + 2 * lane);
                *(unsigned*)((_Float16*)(ws + WS_WS16) + (size_t)r * 128 + 2 * lane) = pk_h2(2 * lane <= tt ? w.x : 0.f, 2 * lane + 1 <= tt ? w.y : 0.f);
            }
        }
    }
    SEAM(0);

    if (IN(1)) {
        {
            const int per = (NB * 3 * DM) / G;
            for (int i = tid; i < per; i += 512) {
                const int e = blk * per + i, b = e / (3 * DM), j = e % (3 * DM);
                float s = a.b_ada[j];
                for (int ks = 0; ks < KSPLIT; ++ks) s += MODP[((size_t)ks * NB + b) * (3 * DM) + j];
                MOD[e] = s;
            }
        }
        const int rows_per = NT / G;
        const int b = (blk * rows_per) / SEQ;
        LAS float* sh = (LAS float*)lds;
#pragma unroll 1
        for (int j4 = tid; j4 < 2 * DM / 4; j4 += 512) {
            f32x4 pv[KSPLIT];
#pragma unroll
            for (int ks = 0; ks < KSPLIT; ++ks) pv[ks] = *(const f32x4*)(MODP + ((size_t)ks * NB + b) * (3 * DM) + 4 * j4);
            f32x4 s4 = *(const f32x4*)(a.b_ada + 4 * j4);
#pragma unroll
            for (int ks = 0; ks < KSPLIT; ++ks) s4 += pv[ks];
            if (4 * j4 >= DM) s4 = (s4 + 1.0f) * *(const f32x4*)(a.norm_g + 4 * j4 - DM);
            *(LAS f32x4*)(sh + 4 * j4) = s4;
        }
        __syncthreads();
#pragma unroll 1
        for (int r = wave; r < rows_per; r += 8) {
            const int row = blk * rows_per + r;
            asm volatile("" ::: "memory");
            const f32x4* xr = (const f32x4*)(a.x + (size_t)row * DM) + lane;
            f32x4 v[16]; float ss = 0.f;
#pragma unroll
            for (int j = 0; j < 16; ++j) { v[j] = __builtin_nontemporal_load(xr + 64 * j); ss += (v[j].x * v[j].x + v[j].y * v[j].y) + (v[j].z * v[j].z + v[j].w * v[j].w); }
            const float rstd = 1.0f / sqrtf(wave_sum(ss) * (1.0f / DM) + EPS);
            u32x2* o8 = (u32x2*)(H + (size_t)row * DM) + lane; unsigned* o4 = (unsigned*)(ws + WS_H8 + (size_t)row * DM) + lane;
#pragma unroll
            for (int j = 0; j < 16; ++j) {
                const int col = 256 * j + 4 * lane;
                const f32x4 sf = *(const LAS f32x4*)(sh + col), sc = *(const LAS f32x4*)(sh + DM + col);
                const f32x4 hv = v[j] * rstd * sc + sf;
                u32x2 w; w.x = pk_h2(hv.x, hv.y); w.y = pk_h2(hv.z, hv.w); o8[64 * j] = w;
                o4[64 * j] = pk_fp8x4(hv.x * H8_S, hv.y * H8_S, hv.z * H8_S, hv.w * H8_S);
                if ((j & 3) == 3) asm volatile("" ::: "memory");
            }
        }
    }
    SEAM(1);

    if (IN(2)) {
        unsigned* done5 = (unsigned*)ws + XCD_BAR_WORDS;
        {
            pg8::Gemm g8{ws + WS_H8, ws + WS_W8IN - (size_t)F8LO * 256 * DM, NT, F8N * 256, DM}; pg8::StaticOrder S8; S8.init(NT, F8N * 256, G, blk, 0, F8LO);
            EpiZ E8{ws, WI, VSTAT, done5, 1.0f / (H8_S * W8_S), (F8N >= 24) ? (F8N * 32 / 256 - 1) : -1};
            pg8::gemm_phase<EpiZ, true, true, true>(lds, g8, S8, E8);
        }
        __syncthreads();
        pg8::Gemm g{H, WTin, NT, NZP - F8N * 256, DM}; pg8::StaticOrder S; S.init(NT, NZP - F8N * 256, G, blk, F8LO, F8N);
        EpiZ E{ws, WI, VSTAT, done5, 1.0f, (24 - F8N + 3) / 4 - 1};
        pg8::gemm_phase<EpiZ>(lds, g, S, E);
        if (gmlp_pre > 0 && blk >= 160) {
            if (tid == 0) {
                unsigned sp_ = 0;
                while (__hip_atomic_load(done5, __ATOMIC_RELAXED, __HIP_MEMORY_SCOPE_AGENT) < (unsigned)G) { __builtin_amdgcn_s_sleep(2); if (++sp_ > (1u << 22)) break; }
                __builtin_amdgcn_fence(__ATOMIC_ACQUIRE, "agent");
                asm volatile("s_waitcnt vmcnt(0)" ::: "memory");
            }
            __syncthreads();
            const GmlpPar gp{a.ln_v_g, a.ln_v_b, a.b_s, a.out_norm_a_g};
            const int u0 = (blk - 160) * GM_UPI;
#pragma unroll 1
            for (int k = 0; k < GM_UPI; ++k) gmlp_unit(u0 + k, UBl, VBl, GABl, (const _Float16*)(ws + WS_WS16), VSTAT, Y, SSQA, gp, lds, tid, lane, wave);
        }
    }
    SEAM(2);

    if (IN(3)) {
        {
            _Float16* KNw = (_Float16*)(ws + WS_KN);
            constexpr int KN_IT = NT / 2048;
            int lane_k = lane; asm volatile("" : "+v"(lane_k));
            h8 kv[KN_IT];
#pragma unroll
            for (int i = 0; i < KN_IT; ++i) { const int tok = gw + i * NGW; kv[i] = (tok < NT) ? __builtin_nontemporal_load((const h8*)(KBm + (size_t)tok * 512 + 8 * lane_k)) : (h8){0, 0, 0, 0, 0, 0, 0, 0}; }
#pragma unroll
            for (int i = 0; i < KN_IT; ++i) {
                const int tok = gw + i * NGW;
                float f[8], ss = 0.f;
#pragma unroll
                for (int j = 0; j < 8; ++j) { f[j] = (float)kv[i][j]; ss += f[j] * f[j]; }
                ss = sum16(ss);
                const float rk = 1.0f / sqrtf(ss * (1.0f / 128.0f) + EPS);
                u32x4 w; w.x = pk_h2(f[0] * rk, f[1] * rk); w.y = pk_h2(f[2] * rk, f[3] * rk); w.z = pk_h2(f[4] * rk, f[5] * rk); w.w = pk_h2(f[6] * rk, f[7] * rk);
                if (tok < NT) *(u32x4*)(KNw + (size_t)tok * 512 + 8 * lane_k) = w;
            }
            for (int tok = gw + KN_IT * NGW; tok < NT; tok += NGW) {
                const h8 k8 = *(const h8*)(KBm + (size_t)tok * 512 + 8 * lane_k);
                float f[8], ss = 0.f;
#pragma unroll
                for (int j = 0; j < 8; ++j) { f[j] = (float)k8[j]; ss += f[j] * f[j]; }
                ss = sum16(ss);
                const float rk = 1.0f / sqrtf(ss * (1.0f / 128.0f) + EPS);
                u32x4 w; w.x = pk_h2(f[0] * rk, f[1] * rk); w.y = pk_h2(f[2] * rk, f[3] * rk); w.z = pk_h2(f[4] * rk, f[5] * rk); w.w = pk_h2(f[6] * rk, f[7] * rk);
                *(u32x4*)(KNw + (size_t)tok * 512 + 8 * lane_k) = w;
            }
        }
        {
            LAS unsigned char* ring = lds;
            LAS float* scw = (LAS float*)(lds + 65536) + wave * SEQ;
            const int r32 = lane & 31, hi = lane >> 5;
            unsigned voffI[2];
#pragma unroll
            for (int i = 0; i < 2; ++i) { const int Gn = (wave * 2 + i) * 64 + lane, row = Gn >> 4, cg = (Gn & 15) ^ (row & 15); voffI[i] = (unsigned)(row * 128 + cg * 8); }
            for (int un = blk; un < 512; un += G) {
                const int jj = un & 255, b = 2 * (jj >> 7) + (un >> 8), qb = (un >> 8) ? 127 - (jj & 127) : (jj & 127);
                const int q0 = 16 * qb, tA = q0 + 2 * wave, tB = tA + 1;
                const int ngr = (q0 + 15) / 64 + 1;
                const size_t tokA = (size_t)b * SEQ + tA;
                const _Float16* kib = KIm + (size_t)b * SEQ * 128;
                h8 qaA[8], qaB[8]; float wA[16], wB[16];
                {
                    int r32_p = r32, hi_p = hi; asm volatile("" : "+v"(r32_p), "+v"(hi_p));
                    const _Float16* qp = QIm + tokA * 4096 + r32_p * 128 + 8 * hi_p;
#pragma unroll
                    for (int kk = 0; kk < 8; ++kk) { qaA[kk] = *(const h8*)(qp + 16 * kk); qaB[kk] = *(const h8*)(qp + 4096 + 16 * kk); }
                    const float* wp = WI + tokA * 32 + 4 * hi_p;
#pragma unroll
                    for (int r = 0; r < 16; ++r) { wA[r] = wp[(r & 3) + 8 * (r >> 2)]; wB[r] = wp[32 + (r & 3) + 8 * (r >> 2)]; }
                }
                float scB[32];
#pragma unroll
                for (int i = 0; i < 32; ++i) scB[i] = 0.f;
                __syncthreads();
#define IDX_DMA(c_) do { _Pragma("unroll") for (int i_ = 0; i_ < 2; ++i_) \
        __builtin_amdgcn_global_load_lds((const unsigned*)(kib + (size_t)(64 * (c_)) * 128 + voffI[i_]), (LAS unsigned*)(ring + ((c_) & 3) * 16384 + (wave * 2 + i_) * 1024), 16, 0, 0); } while (0)
                IDX_DMA(0); if (1 < ngr) IDX_DMA(1); if (2 < ngr) IDX_DMA(2);
                const bool grpY = wave >= 4;
                f32x16 aA0, aB0, aA1, aB1;
                int cpend = -1;
#define IDX_EPI(cc_) do { \
                    float sa = 0.f, sb = 0.f, sc1 = 0.f, sd = 0.f; \
                    _Pragma("unroll") for (int r = 0; r < 16; ++r) {     \
                        sa = __builtin_fmaf(wA[r], relu1(aA0[r]), sa); sb = __builtin_fmaf(wB[r], relu1(aB0[r]), sb); \
                        sc1 = __builtin_fmaf(wA[r], relu1(aA1[r]), sc1); sd = __builtin_fmaf(wB[r], relu1(aB1[r]), sd); } \
                      \
                    const auto swA_ = __builtin_amdgcn_permlane32_swap(__float_as_uint(sa), __float_as_uint(sc1), false, false);     \
                    const auto swB_ = __builtin_amdgcn_permlane32_swap(__float_as_uint(sb), __float_as_uint(sd), false, false); \
                    const float totA = __uint_as_float(swA_[0]) + __uint_as_float(swA_[1]), totB = __uint_as_float(swB_[0]) + __uint_as_float(swB_[1]); \
                    scw[64 * (cc_) + lane] = totA; \
                    _Pragma("unroll") for (int i = 0; i < 32; ++i) scB[i] = (i == (cc_)) ? totB : scB[i]; \
                } while (0)
#pragma unroll 1
                for (int c = 0; c < ngr; ++c) {
                    const int rem = ngr - 1 - c;
                    if (rem >= 2) asm volatile("s_waitcnt vmcnt(4)" ::: "memory"); else if (rem == 1) asm volatile("s_waitcnt vmcnt(2)" ::: "memory"); else asm volatile("s_waitcnt vmcnt(0)" ::: "memory");
                    __builtin_amdgcn_s_barrier();
                    asm volatile("" ::: "memory");
                    if (c + 3 < ngr) IDX_DMA(c + 3);
                    {
                        const LAS unsigned char* rb = ring + (c & 3) * 16384;
                        const LAS unsigned char* rp0 = rb + r32 * 256;
                        h8 f0[8], f1[8];
#pragma unroll
                        for (int kk = 0; kk < 4; ++kk) f0[kk] = *(const LAS h8*)(rp0 + (((2 * kk + hi) ^ (r32 & 15)) << 4));
                        if (grpY && cpend >= 0) { IDX_EPI(cpend); cpend = -1; }
#pragma unroll
                        for (int kk = 4; kk < 8; ++kk) f0[kk] = *(const LAS h8*)(rp0 + (((2 * kk + hi) ^ (r32 & 15)) << 4));
#pragma unroll
                        for (int kk = 0; kk < 8; ++kk) f1[kk] = *(const LAS h8*)(rp0 + 8192 + (((2 * kk + hi) ^ (r32 & 15)) << 4));
#pragma unroll
                        for (int r = 0; r < 16; ++r) { aA0[r] = 0.f; aB0[r] = 0.f; aA1[r] = 0.f; aB1[r] = 0.f; }
                        __builtin_amdgcn_s_setprio(1);
#pragma unroll
                        for (int kk = 0; kk < 8; ++kk) {
                            aA0 = __builtin_amdgcn_mfma_f32_32x32x16_f16(qaA[kk], f0[kk], aA0, 0, 0, 0);
                            aB0 = __builtin_amdgcn_mfma_f32_32x32x16_f16(qaB[kk], f0[kk], aB0, 0, 0, 0);
                        }
#pragma unroll
                        for (int kk = 0; kk < 8; ++kk) {
                            aA1 = __builtin_amdgcn_mfma_f32_32x32x16_f16(qaA[kk], f1[kk], aA1, 0, 0, 0);
                            aB1 = __builtin_amdgcn_mfma_f32_32x32x16_f16(qaB[kk], f1[kk], aB1, 0, 0, 0);
                        }
                        __builtin_amdgcn_s_setprio(0);
                        if (grpY) cpend = c; else IDX_EPI(c);
                    }
                }
                if (grpY && cpend >= 0) IDX_EPI(cpend);
#undef IDX_EPI
#undef IDX_DMA
                {
                    unsigned uk[32];
                    int lane_o = lane; asm volatile("" : "+v"(lane_o));
                    const LAS float* sl = scw + lane_o;
#pragma unroll
                    for (int i = 0; i < 32; ++i) { const unsigned bits = __float_as_uint(sl[64 * i]); uk[i] = (64 * i + lane_o <= tA) ? ((bits & 0x80000000u) ? ~bits : (bits | 0x80000000u)) : 0u; }
                    asm volatile("s_waitcnt lgkmcnt(0)" ::: "memory");
                    topk_select(uk, tA, MASK + tokA * 64, lane_o, (LAS unsigned*)scw);
#pragma unroll
                    for (int i = 0; i < 32; ++i) { const unsigned bits = __float_as_uint(scB[i]); uk[i] = (64 * i + lane_o <= tB) ? ((bits & 0x80000000u) ? ~bits : (bits | 0x80000000u)) : 0u; }
                    topk_select(uk, tB, MASK + (tokA + 1) * 64, lane_o, (LAS unsigned*)scw);
                }
            }
        }
        __syncthreads();
        {
            const GmlpPar gp{a.ln_v_g, a.ln_v_b, a.b_s, a.out_norm_a_g};
            for (int un = gmlp_pre + blk; un < NB * 16 * 16; un += G) gmlp_unit(un, UBl, VBl, GABl, (const _Float16*)(ws + WS_WS16), VSTAT, Y, SSQA, gp, lds, tid, lane, wave);
        }
    }
    SEAM(3);

    if (IN(4)) {
        using namespace att;
        const int r32 = lane & 31, hi = lane >> 5, hr = wave & 3, qh = wave >> 2;
        LAS unsigned char* V_lds = lds + L_V; LAS unsigned char* K_lds = lds + L_K;
        LAS unsigned* mask_l = (LAS unsigned*)(lds + L_MSK); LAS float* li_l = (LAS float*)(lds + L_LI) + wave * 32;
        LAS float* dtab = (LAS float*)(lds + L_DT); LAS int* bucket = (LAS int*)(lds + L_BK);
        const _Float16* KN = (const _Float16*)(ws + WS_KN);
        const int vb0 = (int)(uintptr_t)V_lds + v_rd_base(lane);
        unsigned voffV[2], voffK[2];
#pragma unroll
        for (int i = 0; i < 2; ++i) {
            const int Gn = (wave * 2 + i) * 64 + lane;
            const int kk = ((Gn >> 7) << 3) | ((Gn >> 2) & 7), c = ((Gn >> 5) & 3) * 32 + (Gn & 3) * 8;
            const int k = (kk & ~0xC) | ((kk & 4) << 1) | ((kk & 8) >> 1);
            voffV[i] = (unsigned)(k * 512 + c);
            const int row = Gn >> 4, cg = (Gn & 15) ^ (row & 7);
            voffK[i] = (unsigned)(row * 512 + cg * 8);
        }
        LAS float* gqk_l = (LAS float*)(lds + L_GQK); LAS float* rb_l = (LAS float*)(lds + L_RB);
        if (tid < 128) {
            const int n = tid; int bk;
            if (n < 16) bk = n; else { bk = 16 + (int)(logf((float)n / 16.0f) / 2.0794415416798357f * 16.0f); bk = bk < 31 ? bk : 31; }
            bucket[n] = bk;
            gqk_l[n] = a.q_norm_g[n] * a.k_norm_g[n] * (1.44269504089f * 0.08838834764831845f);
        }
        rb_l[tid] = a.rel_bias[tid];
        for (int cu0 = blk; cu0 < 256; cu0 += G) {
            const int cu = (G == 256) ? (((cu0 & 7) * 2 + (cu0 >> 7)) * 16 + ((cu0 >> 3) & 15)) : cu0;
            const int bg = cu >> 4, b = bg >> 2, g = bg & 3, ci = cu & 15;
            const int h = 4 * g + hr;
            __syncthreads();
            int tid_o = tid; asm volatile("" : "+v"(tid_o));
            for (int i = tid_o; i < 1024; i += 512) {
                const int hh = i >> 8, dist = (i & 255) - 64;
                float v = 0.f;
                if (dist >= 0 && dist < 113) v = (rb_l[bucket[dist] * 16 + 4 * g + hh] - rb_l[31 * 16 + 4 * g + hh]) * 1.44269504089f;
                dtab[i] = v;
            }
            const _Float16* Kh = KN + (size_t)b * SEQ * 512 + g * 128; const _Float16* Vh = VVm + (size_t)b * SEQ * 512 + g * 128;
#pragma unroll 1
            for (int uu = 0; uu < 2; ++uu) {
                const int qb = uu == 0 ? (31 - ci) : ci;
                const int NTL = qb + 1;
                const int ql = 32 * qh + r32, t = 64 * qb + ql;
#define ATT_DMA(bf, k0) do { _Pragma("unroll") for (int i_ = 0; i_ < 2; ++i_) { \
        __builtin_amdgcn_global_load_lds((const unsigned*)(Vh + (size_t)(k0) * 512 + voffV[i_]), (LAS unsigned*)(V_lds + (bf) * 16384 + (wave * 2 + i_) * 1024), 16, 0, 0); \
        __builtin_amdgcn_global_load_lds((const unsigned*)(Kh + (size_t)(k0) * 512 + voffK[i_]), (LAS unsigned*)(K_lds + (bf) * 16384 + (wave * 2 + i_) * 1024), 16, 0, 0); } } while (0)
                __syncthreads();
                ATT_DMA(0, 0);
                {
                    const unsigned* mg = MASK + ((size_t)b * SEQ + 64 * qb) * 64;
                    int tid_m = tid; asm volatile("" : "+v"(tid_m));
#pragma unroll
                    for (int p = 0; p < 2; ++p) { const int e = p * 512 + tid_m; const u32x4 w = *(const u32x4*)(mg + e * 4); const int q = e >> 4, wq = (e & 15) * 4;
                        LAS unsigned* d = mask_l + q * 66 + wq; *(LAS u32x2*)d = (u32x2){w.x, w.y}; *(LAS u32x2*)(d + 2) = (u32x2){w.z, w.w}; }
                }
                h8 qr[8];
                {
                    int hi_p = hi, t_p = t; asm volatile("" : "+v"(hi_p), "+v"(t_p));
                    const _Float16* qp = QBm + ((size_t)b * SEQ + t_p) * 2048 + h * 128 + 8 * hi_p;
                    float ss = 0.f;
#pragma unroll
                    for (int d0 = 0; d0 < 8; ++d0) { qr[d0] = *(const h8*)(qp + 16 * d0);
#pragma unroll
                        for (int j = 0; j < 8; ++j) { const float f = (float)qr[d0][j]; ss += f * f; } }
                    ss = xsum32(ss);
                    const float rs = 1.0f / sqrtf(ss * (1.0f / 128.0f) + EPS);
#pragma unroll
                    for (int d0 = 0; d0 < 8; ++d0) {
                        const f32x4 g0 = *(const LAS f32x4*)(gqk_l + 16 * d0 + 8 * hi_p), g1 = *(const LAS f32x4*)(gqk_l + 16 * d0 + 8 * hi_p + 4);
                        h8 o8;
#pragma unroll
                        for (int j = 0; j < 4; ++j) { o8[j] = (_Float16)((float)qr[d0][j] * rs * g0[j]); o8[4 + j] = (_Float16)((float)qr[d0][4 + j] * rs * g1[j]); }
                        qr[d0] = o8;
                    }
                }
                f32x16 o[4];
#pragma unroll
                for (int d = 0; d < 4; ++d)
#pragma unroll
                    for (int r = 0; r < 16; ++r) o[d][r] = 0.f;
                float lsum = 0.f;
                const LAS unsigned* mq = mask_l + ql * 66;
                __syncthreads();
#define ATT_PK4(P, BASE, OUT) do { unsigned a0 = cvtpk_bf16(P[BASE + 0], P[BASE + 1]), a1 = cvtpk_bf16(P[BASE + 2], P[BASE + 3]); \
        unsigned b0 = cvtpk_bf16(P[BASE + 4], P[BASE + 5]), b1 = cvtpk_bf16(P[BASE + 6], P[BASE + 7]); \
        auto r0 = __builtin_amdgcn_permlane32_swap(a0, b0, false, false); auto r1 = __builtin_amdgcn_permlane32_swap(a1, b1, false, false); \
        u32x4 w = {r0[0], r1[0], r0[1], r1[1]}; OUT = __builtin_bit_cast(bf16x8, w); } while (0)
#define ATT_TILE(BF, J) do { \
                    const int j_ = (J); \
                    if (j_ + 1 < NTL) ATT_DMA((BF) ^ 1, 64 * (j_ + 1)); \
                    f32x16 p0, p1; \
                    qkt(p0, p1, K_lds + (BF) * 16384, qr, r32, hi); \
                    { \
                        const u32x2 mw = *(const LAS u32x2*)(mq + 2 * j_); \
                        const unsigned w0 = mw.x >> (4 * hi), w1 = mw.y >> (4 * hi); \
                        if (j_ >= NTL - 3) { \
                            const LAS float* dt = dtab + hr * 256 + (t - 64 * j_ + 64 - 4 * hi - 63); \
                            _Pragma("unroll") for (int r = 0; r < 16; ++r) { const int c = (r & 3) + 8 * (r >> 2); p0[r] += dt[63 - c]; p1[r] += dt[63 - c - 32]; } \
                        } \
                        _Pragma("unroll") for (int r = 0; r < 16; ++r) { \
                            const int c = (r & 3) + 8 * (r >> 2); \
                            const float e0 = __builtin_amdgcn_exp2f(p0[r]), e1 = __builtin_amdgcn_exp2f(p1[r]); \
                            p0[r] = ((w0 >> c) & 1u) ? e0 : 0.f; p1[r] = ((w1 >> c) & 1u) ? e1 : 0.f; \
                            lsum += p0[r] + p1[r]; \
                        } \
                    } \
                    bf16x8 pa0, pa1, pa2, pa3; \
                    ATT_PK4(p0, 0, pa0); ATT_PK4(p0, 8, pa1); ATT_PK4(p1, 0, pa2); ATT_PK4(p1, 8, pa3); \
                    ATT_SBAR(); \
                    const int vb = vb0 + (BF) * 16384; \
                    pv_one<0>(o[0], vb, pa0, pa1, pa2, pa3); pv_one<1>(o[1], vb, pa0, pa1, pa2, pa3); pv_one<2>(o[2], vb, pa0, pa1, pa2, pa3); pv_one<3>(o[3], vb, pa0, pa1, pa2, pa3); \
                    __syncthreads(); \
                } while (0)
                {
                    int j = 0;
#pragma unroll 1
                    for (; j + 1 < NTL; j += 2) { ATT_TILE(0, j); ATT_TILE(1, j + 1); }
                    if (j < NTL) ATT_TILE(0, j);
                }
#undef ATT_TILE
                int t_e = 64 * qb + 32 * qh, r32_e = r32, hi_e = hi; asm volatile("" : "+v"(t_e), "+v"(r32_e), "+v"(hi_e));
                lsum = xsum32(lsum);
                if (hi_e == 0) li_l[r32_e] = lsum;
                asm volatile("s_waitcnt lgkmcnt(0)" ::: "memory");
                LAS _Float16* ot = (LAS _Float16*)(lds + L_V) + wave * 4096;
#pragma unroll
                for (int r = 0; r < 16; ++r) {
                    const int qrow = crow(r, hi_e);
                    const float rl = __builtin_amdgcn_rcpf(li_l[qrow]);
                    float ssq = 0.f;
#pragma unroll
                    for (int d0 = 0; d0 < 4; ++d0) { const float ov = o[d0][r] * rl; ssq += ov * ov; ot[qrow * 128 + 32 * d0 + r32_e] = (_Float16)ov; }
                    ssq = sum32(ssq);
                    if (r32_e == 0) SSQB[((size_t)b * SEQ + t_e + qrow) * 16 + h] = ssq;
                }
                asm volatile("s_waitcnt lgkmcnt(0)" ::: "memory");
                {
                    int lane_e = lane; asm volatile("" : "+v"(lane_e));
                    const int c16 = lane_e & 15, qs = lane_e >> 4;
                    const f32x4 og0 = *(const f32x4*)(a.out_norm_b_g + h * 128 + 8 * c16) * Y8_SB, og1 = *(const f32x4*)(a.out_norm_b_g + h * 128 + 8 * c16 + 4) * Y8_SB;
#pragma unroll
                    for (int hf = 0; hf < 2; ++hf) {
                    h8 gbv[4], ovv[4];
#pragma unroll
                    for (int i = 0; i < 4; ++i) {
                        const int q = qs + 4 * (4 * hf + i); const size_t tk = (size_t)b * SEQ + t_e + q;
                        gbv[i] = __builtin_nontemporal_load((const h8*)(GBm + tk * 2048 + h * 128 + 8 * c16));
                        ovv[i] = *(const LAS h8*)(ot + q * 128 + 8 * c16);
                    }
#pragma unroll
                    for (int i = 0; i < 4; ++i) {
                        const int q = qs + 4 * (4 * hf + i); const size_t tk = (size_t)b * SEQ + t_e + q;
                        u32x2 w;
                        w.x = pk_fp8x4((float)ovv[i][0] * og0[0] * (float)gbv[i][0], (float)ovv[i][1] * og0[1] * (float)gbv[i][1], (float)ovv[i][2] * og0[2] * (float)gbv[i][2], (float)ovv[i][3] * og0[3] * (float)gbv[i][3]);
                        w.y = pk_fp8x4((float)ovv[i][4] * og1[0] * (float)gbv[i][4], (float)ovv[i][5] * og1[1] * (float)gbv[i][5], (float)ovv[i][6] * og1[2] * (float)gbv[i][6], (float)ovv[i][7] * og1[3] * (float)gbv[i][7]);
                        *(u32x2*)(Y + tk * DM + 2048 + h * 128 + 8 * c16) = w;
                    }
                    asm volatile("" ::: "memory");
                    }
                }
#undef ATT_DMA
#undef ATT_PK4
            }
        }
    }
    SEAM(4);

    if (IN(5)) {
        pg8::Gemm g{Y, WTout, NT, DM, DM}; pg8::StaticOrder S; S.init(NT, DM, G, blk);
        EpiOut E{a.x, a.out, MOD, SSQA, SSQB};
        pg8::gemm_phase<EpiOut, true, true, true>(lds, g, S, E);
    }
#undef IN
#undef SEAM
}

extern "C" void kernel_launch(void* const* d_in, const int* in_sizes, int n_in, void* d_out, int out_size, void* d_ws, size_t ws_size, hipStream_t stream) {
    static int grid = 0;
    if (grid == 0) {
        if (n_in != 16 || out_size != NT * DM || ws_size < WS_END) { fprintf(stderr, "kernel_launch: unexpected shapes (n_in %d out %d ws %zu)\n", n_in, out_size, ws_size); grid = -1; return; }
        int dev = 0, cus = 0, per_cu = 0;
        hipGetDevice(&dev);
        hipDeviceGetAttribute(&cus, hipDeviceAttributeMultiprocessorCount, dev);
        hipFuncSetAttribute((const void*)fwd_kernel, hipFuncAttributeMaxDynamicSharedMemorySize, LDS_BYTES);
        hipOccupancyMaxActiveBlocksPerMultiprocessor(&per_cu, (const void*)fwd_kernel, 512, LDS_BYTES);
        if (per_cu < 1) { fprintf(stderr, "kernel_launch: occupancy query says %d blocks per CU\n", per_cu); grid = -1; return; }
        grid = cus;
        if (grid > 256) grid = 256;
        (void)hipGetLastError();
    }
    if (grid < 0) return;
    Args a{};
    a.x = (const float*)d_in[0]; a.c = (const float*)d_in[1]; a.w_ada = (const float*)d_in[2]; a.b_ada = (const float*)d_in[3]; a.norm_g = (const float*)d_in[4];
    a.w_in = (const float*)d_in[5]; a.ln_v_g = (const float*)d_in[6]; a.ln_v_b = (const float*)d_in[7]; a.w_s = (const float*)d_in[8]; a.b_s = (const float*)d_in[9];
    a.q_norm_g = (const float*)d_in[10]; a.k_norm_g = (const float*)d_in[11]; a.rel_bias = (const float*)d_in[12]; a.out_norm_a_g = (const float*)d_in[13];
    a.out_norm_b_g = (const float*)d_in[14]; a.w_out = (const float*)d_in[15];
    a.out = (float*)d_out; a.ws = (unsigned char*)d_ws; a.ph_lo = 0; a.ph_hi = 6;
    (void)hipMemsetAsync(d_ws, 0, XCD_BAR_WORDS * 4 + 256, stream);
    void* args[] = {&a};
    hipError_t e = hipLaunchCooperativeKernel((const void*)fwd_kernel, dim3(grid), dim3(512), args, LDS_BYTES, stream);
    if (e != hipSuccess) fprintf(stderr, "kernel_launch: cooperative launch failed: %s (grid %d)\n", hipGetErrorString(e), grid);
}
```
